# Optimizing an MI355X kernel written in HIP

```python
import math
import jax, jax.numpy as jnp
from jax import lax
import numpy as np

D_MODEL = 1024
BATCH = 8
SEQ = 2048
DEPTH = 1
DEC_BATCH = 16
DEC_SEQ = 64
PAST_LEN = 2048

CHUNK = 64
Q_BLOCK = 128
HEAD_DIM = 64
DIFF_HEADS = 4
SB_HEADS = 8
DIFF_WIDTH = DIFF_HEADS * 2 * HEAD_DIM
SB_WIDTH = SB_HEADS * HEAD_DIM
MIX_WIDTH = DIFF_WIDTH + SB_WIDTH
IN_WIDTH = 3 * MIX_WIDTH
D_FF = 4 * D_MODEL
EPS = 1e-6
NEG = -1e30

kernel_name = 'hymba_diff_stickbreaking_streaming_step'


def rmsnorm(x, g):
    xf = x.astype(jnp.float32)
    y = xf * lax.rsqrt(jnp.mean(xf * xf, axis=-1, keepdims=True) + EPS)
    return (y * g.astype(jnp.float32)).astype(x.dtype)


def alibi_slopes():
    return jnp.asarray(2.0 ** (-8.0 * np.arange(1, DIFF_HEADS + 1) / DIFF_HEADS), dtype=jnp.float32)


def lambda_init(layer):
    return 0.8 - 0.6 * math.exp(-0.3 * layer)


def modulate(c, w_ada, b_ada):
    m = jax.nn.silu(c) @ w_ada + b_ada
    return jnp.split(m[:, None, :], 6, axis=-1)


def split_proj(u):
    b, t, _ = u.shape
    cuts = [DIFF_WIDTH, 2 * DIFF_WIDTH, 3 * DIFF_WIDTH, 3 * DIFF_WIDTH + SB_WIDTH, 3 * DIFF_WIDTH + 2 * SB_WIDTH]
    qd, kd, vd, qs, ks, vs = jnp.split(u, cuts, axis=-1)
    qd = qd.reshape(b, t, DIFF_HEADS, 2, HEAD_DIM)
    kd = kd.reshape(b, t, DIFF_HEADS, 2 * HEAD_DIM)
    vd = vd.reshape(b, t, DIFF_HEADS, 2 * HEAD_DIM)
    qs = qs.reshape(b, t, SB_HEADS, HEAD_DIM)
    ks = ks.reshape(b, t, SB_HEADS, HEAD_DIM)
    vs = vs.reshape(b, t, SB_HEADS, HEAD_DIM)
    return qd, kd, vd, qs, ks, vs


def mix_queries(qd, qs, q_pos, kd, vd, ks, vs, k_pos, lam, subln_g, lam_init):
    f32 = jnp.float32
    b, tk = kd.shape[0], kd.shape[1]
    tq = qd.shape[1]
    scale = HEAD_DIM ** -0.5
    kd2 = kd.reshape(b, tk, DIFF_HEADS, 2, HEAD_DIM)
    s = jnp.einsum('bqhmd,bkhmd->bhmqk', qd.astype(f32), kd2.astype(f32)) * scale
    dist = jnp.abs(q_pos[:, None] - k_pos[None, :]).astype(f32)
    s = s - alibi_slopes()[None, :, None, None, None] * dist
    visible = (k_pos[None, :] // CHUNK) <= (q_pos[:, None] // CHUNK)
    p = jax.nn.softmax(jnp.where(visible, s, NEG), axis=-1)
    a = p[:, :, 0] - lam * p[:, :, 1]
    od = jnp.einsum('bhqk,bkhe->bqhe', a, vd.astype(f32))
    od = rmsnorm(od, subln_g) * (1.0 - lam_init)
    z = jnp.einsum('bqhd,bkhd->bhqk', qs.astype(f32), ks.astype(f32)) * scale
    earlier = k_pos[None, :] < q_pos[:, None]
    log_keep = jnp.where(earlier, jax.nn.log_sigmoid(-z), 0.0)
    between = lax.cumsum(log_keep, axis=3, reverse=True) - log_keep
    w = jnp.where(earlier, jnp.exp(jax.nn.log_sigmoid(z) + between), 0.0)
    osb = jnp.einsum('bhqk,bkhd->bqhd', w, vs.astype(f32))
    return jnp.concatenate([od.reshape(b, tq, DIFF_WIDTH), osb.reshape(b, tq, SB_WIDTH)], axis=-1)


def prompt_mix(qd, kd, vd, qs, ks, vs, lam, subln_g, lam_init):
    b, s = qd.shape[0], qd.shape[1]
    nblk = s // Q_BLOCK
    k_pos = jnp.arange(s)
    qd_blocks = qd.reshape(b, nblk, Q_BLOCK, DIFF_HEADS, 2, HEAD_DIM).swapaxes(0, 1)
    qs_blocks = qs.reshape(b, nblk, Q_BLOCK, SB_HEADS, HEAD_DIM).swapaxes(0, 1)

    def blk(args):
        i, qd_b, qs_b = args
        q_pos = i * Q_BLOCK + jnp.arange(Q_BLOCK)
        return mix_queries(qd_b, qs_b, q_pos, kd, vd, ks, vs, k_pos, lam, subln_g, lam_init)

    out = lax.map(blk, (jnp.arange(nblk), qd_blocks, qs_blocks))
    return out.swapaxes(0, 1).reshape(b, s, MIX_WIDTH)


def sample_mix(qd, kd, vd, qs, ks, vs, ck_d, cv_d, ck_s, cv_s, lam, subln_g, lam_init):
    past, t = ck_d.shape[1], qd.shape[1]
    q_pos = past + jnp.arange(t)
    k_pos = jnp.arange(past + t)
    kd_all = jnp.concatenate([ck_d.astype(kd.dtype), kd], axis=1)
    vd_all = jnp.concatenate([cv_d.astype(vd.dtype), vd], axis=1)
    ks_all = jnp.concatenate([ck_s.astype(ks.dtype), ks], axis=1)
    vs_all = jnp.concatenate([cv_s.astype(vs.dtype), vs], axis=1)
    return mix_queries(qd, qs, q_pos, kd_all, vd_all, ks_all, vs_all, k_pos, lam, subln_g, lam_init)


def pre(x, g, shift, scale):
    return rmsnorm(x, g) * (1.0 + scale) + shift


def post_add(x, y, g, gate):
    return x + gate * rmsnorm(y, g)


def ffn(h, w_up, w_down):
    return jnp.square(jax.nn.relu(h @ w_up)) @ w_down


def setup_inputs(seed: int = 0) -> dict:
    key = jax.random.key(seed)
    ks = jax.random.split(key, 24)
    f32 = jnp.float32
    nrm = lambda k, shape, s: jax.random.normal(k, shape, f32) * s
    gain = lambda k, shape: 1.0 + 0.1 * jax.random.normal(k, shape, f32)
    return {
        'x_prompt': nrm(ks[0], (BATCH, SEQ, D_MODEL), 1.0),
        'x_sample': nrm(ks[1], (DEC_BATCH, DEC_SEQ, D_MODEL), 1.0),
        'c_prompt': nrm(ks[2], (BATCH, D_MODEL), 1.0),
        'c_sample': nrm(ks[3], (DEC_BATCH, D_MODEL), 1.0),
        'cache_diff_k': nrm(ks[4], (DEPTH, DEC_BATCH, PAST_LEN, DIFF_HEADS, 2 * HEAD_DIM), 1.0),
        'cache_diff_v': nrm(ks[5], (DEPTH, DEC_BATCH, PAST_LEN, DIFF_HEADS, 2 * HEAD_DIM), 1.0),
        'cache_sb_k': nrm(ks[6], (DEPTH, DEC_BATCH, PAST_LEN, SB_HEADS, HEAD_DIM), 1.0),
        'cache_sb_v': nrm(ks[7], (DEPTH, DEC_BATCH, PAST_LEN, SB_HEADS, HEAD_DIM), 1.0),
        'w_ada': nrm(ks[8], (DEPTH, D_MODEL, 6 * D_MODEL), 0.2 * D_MODEL ** -0.5),
        'b_ada': nrm(ks[9], (DEPTH, 6 * D_MODEL), 0.02),
        'g_pre_mix': gain(ks[10], (DEPTH, D_MODEL)),
        'g_post_mix': gain(ks[11], (DEPTH, D_MODEL)),
        'w_in': nrm(ks[12], (DEPTH, D_MODEL, IN_WIDTH), D_MODEL ** -0.5),
        'lambda_q1': nrm(ks[13], (DEPTH, HEAD_DIM), 0.1),
        'lambda_k1': nrm(ks[14], (DEPTH, HEAD_DIM), 0.1),
        'lambda_q2': nrm(ks[15], (DEPTH, HEAD_DIM), 0.1),
        'lambda_k2': nrm(ks[16], (DEPTH, HEAD_DIM), 0.1),
        'diff_subln_g': gain(ks[17], (DEPTH, 2 * HEAD_DIM)),
        'w_out': nrm(ks[18], (DEPTH, MIX_WIDTH, D_MODEL), MIX_WIDTH ** -0.5),
        'g_pre_ffn': gain(ks[19], (DEPTH, D_MODEL)),
        'g_post_ffn': gain(ks[20], (DEPTH, D_MODEL)),
        'w_up': nrm(ks[21], (DEPTH, D_MODEL, D_FF), D_MODEL ** -0.5),
        'w_down': nrm(ks[22], (DEPTH, D_FF, D_MODEL), D_FF ** -0.5),
    }


def reference(x_prompt, x_sample, c_prompt, c_sample, cache_diff_k, cache_diff_v, cache_sb_k, cache_sb_v,
              w_ada, b_ada, g_pre_mix, g_post_mix, w_in, lambda_q1, lambda_k1, lambda_q2, lambda_k2,
              diff_subln_g, w_out, g_pre_ffn, g_post_ffn, w_up, w_down):
    hp, hs = x_prompt, x_sample
    dkp, dvp, skp, svp, dks, dvs, sks, svs = [], [], [], [], [], [], [], []
    for l in range(DEPTH):
        lam_init = lambda_init(l)
        f32 = jnp.float32
        lam = (jnp.exp(jnp.sum(lambda_q1[l].astype(f32) * lambda_k1[l].astype(f32)))
               - jnp.exp(jnp.sum(lambda_q2[l].astype(f32) * lambda_k2[l].astype(f32))) + lam_init)
        sh1p, sc1p, ga1p, sh2p, sc2p, ga2p = modulate(c_prompt, w_ada[l], b_ada[l])
        sh1s, sc1s, ga1s, sh2s, sc2s, ga2s = modulate(c_sample, w_ada[l], b_ada[l])
        qd, kd, vd, qs, ks_, vs = split_proj(pre(hp, g_pre_mix[l], sh1p, sc1p) @ w_in[l])
        mix_p = prompt_mix(qd, kd, vd, qs, ks_, vs, lam, diff_subln_g[l], lam_init).astype(hp.dtype)
        hp = post_add(hp, mix_p @ w_out[l], g_post_mix[l], ga1p)
        hp = post_add(hp, ffn(pre(hp, g_pre_ffn[l], sh2p, sc2p), w_up[l], w_down[l]), g_post_ffn[l], ga2p)
        dkp.append(kd); dvp.append(vd); skp.append(ks_); svp.append(vs)
        qd, kd, vd, qs, ks_, vs = split_proj(pre(hs, g_pre_mix[l], sh1s, sc1s) @ w_in[l])
        mix_s = sample_mix(qd, kd, vd, qs, ks_, vs, cache_diff_k[l], cache_diff_v[l], cache_sb_k[l], cache_sb_v[l],
                           lam, diff_subln_g[l], lam_init).astype(hs.dtype)
        hs = post_add(hs, mix_s @ w_out[l], g_post_mix[l], ga1s)
        hs = post_add(hs, ffn(pre(hs, g_pre_ffn[l], sh2s, sc2s), w_up[l], w_down[l]), g_post_ffn[l], ga2s)
        dks.append(kd); dvs.append(vd); sks.append(ks_); svs.append(vs)
    diff_k_prompt = jnp.stack(dkp)
    diff_v_prompt = jnp.stack(dvp)
    sb_k_prompt = jnp.stack(skp)
    sb_v_prompt = jnp.stack(svp)
    diff_k_sample = jnp.stack(dks)
    diff_v_sample = jnp.stack(dvs)
    sb_k_sample = jnp.stack(sks)
    sb_v_sample = jnp.stack(svs)
    return (hp, hs, diff_k_prompt, diff_v_prompt, sb_k_prompt, sb_v_prompt,
            diff_k_sample, diff_v_sample, sb_k_sample, sb_v_sample)
```

```cpp
#include <hip/hip_runtime.h>
#include <hip/hip_cooperative_groups.h>
#include <cstdio>
#include <cstdint>
namespace cg = cooperative_groups;
namespace pg8 {
#define PG8_LAS __attribute__((address_space(3)))
typedef unsigned short bf16_t;
typedef short bf16x8 __attribute__((ext_vector_type(8)));
typedef float f32x4 __attribute__((ext_vector_type(4)));
typedef unsigned u32x4 __attribute__((ext_vector_type(4)));
constexpr int BM = 256, BK = 64, HALF = 128, HTB = HALF * BK * 2  , STAGE_BYTES = 8 * HTB, NXCD = 8, WGM = 8;

__host__ __device__ __forceinline__ int lds_byte(int r, int c) { const int st = (r >> 4) * 2 + (c >> 5), rr = r & 15, cc = c & 31, ob = rr * 64 + cc * 2; return st * 1024 + (ob ^ (((ob >> 9) & 1) << 5)); }
__host__ __device__ __forceinline__ void stage_rc(int b, int& R, int& C) { const int st = b / 1024, sb = b % 1024, swz = sb ^ (((sb >> 9) & 1) << 5); R = (st >> 1) * 16 + swz / 64; C = (st & 1) * 32 + (swz % 64) / 2; }
__host__ __device__ __forceinline__ int perm32(int rho) { const int n = rho >> 4, i = rho & 15; return 8 * (i >> 2) + 4 * n + (i & 3); }

struct Unit { int pm, pn; };
struct Gemm { const bf16_t* A; const bf16_t* Bt; int M, N, K; };

struct StaticOrder {
    int nM, nN, nwg, G, c;
    __host__ __device__ void init(int M, int N, int G_, int c_) { nM = M / BM; nN = N / BM; nwg = nM * nN; G = G_; c = c_; }
    __host__ __device__ bool next(int i, Unit& u) const {
        const long L = (long)i * G + c; if (L >= nwg) return false;
        int wgid = (int)L; { const int q = nwg / NXCD, r = nwg % NXCD, xcd = wgid % NXCD, off = wgid / NXCD; wgid = (xcd < r ? xcd * (q + 1) : r * (q + 1) + (xcd - r) * q) + off; }
        const int nig = WGM * nN, gid = wgid / nig, fm = gid * WGM, gsz = (nM - fm) < WGM ? (nM - fm) : WGM;
        u.pm = fm + ((wgid % nig) % gsz); u.pn = (wgid % nig) / gsz; return true;
    }
    __device__ __forceinline__ void a_ready(const Unit&) const {}
    __device__ __forceinline__ void done(const Unit&) const {}
};

__device__ __forceinline__ unsigned cvt_pk_bf16(float lo, float hi) { unsigned r; asm volatile("v_cvt_pk_bf16_f32 %0, %1, %2" : "=v"(r) : "v"(lo), "v"(hi)); return r; }
typedef float f32x2 __attribute__((ext_vector_type(2)));
__device__ __forceinline__ f32x2 gelu_pk(f32x2 v) {
    const f32x2 av = __builtin_elementwise_abs(v), d = av * 0.2316418882f + 1.0f;
    f32x2 t; t.x = __builtin_amdgcn_rcpf(d.x); t.y = __builtin_amdgcn_rcpf(d.y);
    f32x2 q = t * 0.5307027145f + (-0.7265760135f); q = q * t + 0.7107068705f; q = q * t + (-0.142248368f); q = q * t + 0.127414796f; q = q * t;
    const f32x2 s = (v * v) * (-0.72134752044f);
    f32x2 e; e.x = __builtin_amdgcn_exp2f(s.x); e.y = __builtin_amdgcn_exp2f(s.y);
    const f32x2 m = v * (q * e), r = v - m;
    f32x2 o; o.x = v.x < 0.f ? m.x : r.x; o.y = v.y < 0.f ? m.y : r.y; return o;
}

template <int ACT  > struct EpiBf16 {
    static constexpr bool PERM = true, AFTER_DRAIN = false; static_assert(ACT == 0 || ACT == 1, "EpiBf16: ACT is 0 (none) or 1 (gelu_pk)");
    bf16_t* O; int ldc; const float* bias; int split_cols; size_t split_stride; float scale0;
    __device__ __forceinline__ void operator()(const f32x4 (&acc)[2][2][4][2], const Unit& u, int wr, int wc, int fr, int fq) const {
        const int row0 = u.pm * BM + wr * 64 + fr; int colt = u.pn * BM; bf16_t* base = O;
        float sc = 1.f; if (split_cols) { const int t = colt / split_cols; base += (size_t)t * split_stride; colt -= t * split_cols; if (t == 0) sc = scale0; }
        const int col0 = colt + wc * 32 + 8 * fq, bcol0 = u.pn * BM + wc * 32 + 8 * fq;
        f32x4 bv[2][2];
#pragma unroll
        for (int bj = 0; bj < 2; ++bj)
#pragma unroll
            for (int n = 0; n < 2; ++n) bv[bj][n] = bias ? *(const f32x4*)(bias + bcol0 + bj * HALF + 4 * n) : (f32x4){0.f, 0.f, 0.f, 0.f};
#pragma unroll
        for (int ai = 0; ai < 2; ++ai)
#pragma unroll
            for (int m = 0; m < 4; ++m) { bf16_t* rowp = base + (size_t)(row0 + ai * HALF + m * 16) * ldc + col0;
#pragma unroll
                for (int bj = 0; bj < 2; ++bj) { f32x4 v0 = acc[ai][bj][m][0] + bv[bj][0], v1 = acc[ai][bj][m][1] + bv[bj][1];
                    if (ACT == 1) { f32x2 a = gelu_pk((f32x2){v0[0], v0[1]}), b = gelu_pk((f32x2){v0[2], v0[3]}), c = gelu_pk((f32x2){v1[0], v1[1]}), d = gelu_pk((f32x2){v1[2], v1[3]});
                        v0 = (f32x4){a.x, a.y, b.x, b.y}; v1 = (f32x4){c.x, c.y, d.x, d.y}; }
                    v0 = v0 * sc; v1 = v1 * sc; u32x4 w; w.x = cvt_pk_bf16(v0[0], v0[1]); w.y = cvt_pk_bf16(v0[2], v0[3]); w.z = cvt_pk_bf16(v1[0], v1[1]); w.w = cvt_pk_bf16(v1[2], v1[3]);
                    *(u32x4*)(rowp + bj * HALF) = w; } }
    }
};

template <class Epi, class Sched, bool ALIGN_EPI = false, bool SP2 = false>
__device__ __forceinline__ void gemm_phase(PG8_LAS unsigned char* lds, const Gemm g, const Sched& S, const Epi& E) {
    const int tid = threadIdx.x, wid = __builtin_amdgcn_readfirstlane(tid >> 6), lane = tid & 63, wr = wid >> 2, wc = wid & 3, fr = lane & 15, fq = lane >> 4;
    const int K = g.K, nt = K / BK;
    unsigned voffA[2], voffB[2];
#pragma unroll
    for (int i = 0; i < 2; ++i) { int R, C; stage_rc(tid * 16 + i * 8192, R, C); const int Rb = Epi::PERM ? ((R & ~31) + perm32(R & 31)) : R;
        voffA[i] = (unsigned)(R * K + C) * 2u; voffB[i] = (unsigned)(Rb * K + C) * 2u; }
    const size_t kstep = (size_t)(BK * 2);
    const size_t hstep = (size_t)HALF * K * 2;
    const size_t tstep = 2 * hstep;
    const unsigned ldsw = (unsigned)wid * 1024u;
    const int aoff = lds_byte(wr * 64 + fr, fq * 8), boff = lds_byte(wc * 32 + fr, fq * 8);
#define PG8_SA(b, h) (((b) * 2 + (h)) * HTB)
#define PG8_SB(b, h) ((4 + (b) * 2 + (h)) * HTB)
#define PG8_STAGE(bufoff, gbase, voff) do { _Pragma("unroll") for (int _i = 0; _i < 2; ++_i) \
        __builtin_amdgcn_global_load_lds((const unsigned*)((const char*)(gbase) + (voff)[_i]), (PG8_LAS unsigned*)(lds + (bufoff) + ldsw + _i * 8192), 16, 0, 0); } while (0)
#define PG8_LDA(dst, b, h) do { _Pragma("unroll") for (int m = 0; m < 4; ++m) _Pragma("unroll") for (int k = 0; k < 2; ++k) dst[m][k] = *(const PG8_LAS bf16x8*)(lds + PG8_SA(b, h) + aoff + m * 2048 + k * 1024); } while (0)
#define PG8_LDB(dst, b, h) do { _Pragma("unroll") for (int n = 0; n < 2; ++n) _Pragma("unroll") for (int k = 0; k < 2; ++k) dst[n][k] = *(const PG8_LAS bf16x8*)(lds + PG8_SB(b, h) + boff + n * 2048 + k * 1024); } while (0)
#define PG8_MMA(ai, bj, At, Bt) do { __builtin_amdgcn_s_setprio(1); _Pragma("unroll") for (int m = 0; m < 4; ++m) _Pragma("unroll") for (int n = 0; n < 2; ++n) _Pragma("unroll") for (int k = 0; k < 2; ++k) \
        acc[ai][bj][m][n] = __builtin_amdgcn_mfma_f32_16x16x32_bf16(Bt[n][k], At[m][k], acc[ai][bj][m][n], 0, 0, 0); __builtin_amdgcn_s_setprio(0); } while (0)
#define PG8_WAIT_V(n) asm volatile("s_waitcnt vmcnt(" #n ")" ::: "memory")
#define PG8_WAIT_L(n) asm volatile("s_waitcnt lgkmcnt(" #n ")" ::: "memory")
#define PG8_BAR __builtin_amdgcn_s_barrier()
#define PG8_SCHED __builtin_amdgcn_sched_barrier(0)
    Unit cur, nxt; int ui = 0;
    if (!S.next(0, cur)) return;
    f32x4 acc[2][2][4][2];
#pragma unroll
    for (int a = 0; a < 2; ++a)
#pragma unroll
        for (int b = 0; b < 2; ++b)
#pragma unroll
            for (int m = 0; m < 4; ++m)
#pragma unroll
                for (int n = 0; n < 2; ++n) acc[a][b][m][n] = (f32x4){0.f, 0.f, 0.f, 0.f};
    bf16x8 At[4][2], B0[2][2], B1[2][2];
    const char* cA = (const char*)g.A + (size_t)cur.pm * tstep; const char* cB = (const char*)g.Bt + (size_t)cur.pn * tstep;
    S.a_ready(cur);
    if constexpr (SP2) {
        PG8_STAGE(PG8_SB(0, 0), cB, voffB); PG8_STAGE(PG8_SB(0, 1), cB + hstep, voffB); PG8_STAGE(PG8_SA(0, 0), cA, voffA); PG8_STAGE(PG8_SA(0, 1), cA + hstep, voffA);
        if (wr == 1) PG8_BAR;
        PG8_WAIT_V(2); PG8_BAR;
        PG8_STAGE(PG8_SB(1, 0), cB + kstep, voffB); PG8_STAGE(PG8_SA(1, 0), cA + kstep, voffA); PG8_STAGE(PG8_SB(1, 1), cB + hstep + kstep, voffB);
        PG8_WAIT_V(6); PG8_BAR;
    } else {
        PG8_STAGE(PG8_SB(0, 0), cB, voffB); PG8_STAGE(PG8_SA(0, 0), cA, voffA); PG8_STAGE(PG8_SB(0, 1), cB + hstep, voffB); PG8_STAGE(PG8_SA(0, 1), cA + hstep, voffA);
        if (wr == 1) PG8_BAR;
        PG8_WAIT_V(4); PG8_BAR;
        PG8_STAGE(PG8_SB(1, 0), cB + kstep, voffB); PG8_STAGE(PG8_SA(1, 0), cA + kstep, voffA); PG8_STAGE(PG8_SB(1, 1), cB + hstep + kstep, voffB);
        PG8_WAIT_V(6); PG8_BAR;
    }
    for (;;) {
        const bool has_next = S.next(ui + 1, nxt);
        const char* nA = has_next ? (const char*)g.A + (size_t)nxt.pm * tstep : cA; const char* nB = has_next ? (const char*)g.Bt + (size_t)nxt.pn * tstep : cB;
        for (int t = 0; t < nt; t += 2) {
            const bool last = (t == nt - 2);
            const char* a1 = cA + (size_t)(t + 1) * kstep;
            const char* a2 = last ? nA : cA + (size_t)(t + 2) * kstep; const char* b2 = last ? nB : cB + (size_t)(t + 2) * kstep;
            const char* a3 = a2 + kstep; const char* b3 = b2 + kstep;
            if (last && has_next) S.a_ready(nxt);
            if constexpr (SP2) {
            PG8_LDB(B0, 0, 0); PG8_LDB(B1, 0, 1); PG8_SCHED; PG8_LDA(At, 0, 0); PG8_STAGE(PG8_SA(1, 1), a1 + hstep, voffA);
            PG8_WAIT_V(8); PG8_WAIT_L(0); PG8_BAR; PG8_MMA(0, 0, At, B0); PG8_MMA(0, 1, At, B1); PG8_BAR; PG8_SCHED;
            PG8_LDA(At, 0, 1); PG8_STAGE(PG8_SB(0, 0), b2, voffB); PG8_STAGE(PG8_SB(0, 1), b2 + hstep, voffB); PG8_STAGE(PG8_SA(0, 0), a2, voffA);
            PG8_WAIT_V(8); PG8_WAIT_L(0); PG8_BAR; PG8_MMA(1, 0, At, B0); PG8_MMA(1, 1, At, B1); PG8_BAR; PG8_SCHED;
            PG8_LDB(B0, 1, 0); PG8_LDB(B1, 1, 1); PG8_SCHED; PG8_LDA(At, 1, 0); PG8_STAGE(PG8_SA(0, 1), a2 + hstep, voffA);
            PG8_WAIT_V(8); PG8_WAIT_L(0); PG8_BAR; PG8_MMA(0, 0, At, B0); PG8_MMA(0, 1, At, B1); PG8_BAR; PG8_SCHED;
            PG8_LDA(At, 1, 1); PG8_STAGE(PG8_SB(1, 0), b3, voffB); PG8_STAGE(PG8_SB(1, 1), b3 + hstep, voffB); PG8_STAGE(PG8_SA(1, 0), a3, voffA);
            PG8_WAIT_V(8); PG8_WAIT_L(0); PG8_BAR; PG8_MMA(1, 0, At, B0); PG8_MMA(1, 1, At, B1); PG8_BAR; PG8_SCHED;
            } else {
            PG8_LDB(B0, 0, 0); PG8_SCHED; PG8_LDA(At, 0, 0); PG8_STAGE(PG8_SA(1, 1), a1 + hstep, voffA);
            PG8_WAIT_L(8); PG8_BAR; PG8_WAIT_L(0); PG8_MMA(0, 0, At, B0); PG8_BAR; PG8_SCHED;
            PG8_LDB(B1, 0, 1); PG8_STAGE(PG8_SB(0, 0), b2, voffB);
            PG8_BAR; PG8_WAIT_L(0); PG8_MMA(0, 1, At, B1); PG8_BAR;
            PG8_LDA(At, 0, 1); PG8_STAGE(PG8_SA(0, 0), a2, voffA);
            PG8_BAR; PG8_WAIT_L(0); PG8_MMA(1, 0, At, B0); PG8_BAR; PG8_SCHED;
            PG8_STAGE(PG8_SB(0, 1), b2 + hstep, voffB);
            PG8_WAIT_V(6); PG8_BAR; PG8_MMA(1, 1, At, B1); PG8_BAR;
            PG8_LDB(B0, 1, 0); PG8_SCHED; PG8_LDA(At, 1, 0); PG8_STAGE(PG8_SA(0, 1), a2 + hstep, voffA);
            PG8_WAIT_L(8); PG8_BAR; PG8_WAIT_L(0); PG8_MMA(0, 0, At, B0); PG8_BAR; PG8_SCHED;
            PG8_LDB(B1, 1, 1); PG8_STAGE(PG8_SB(1, 0), b3, voffB);
            PG8_BAR; PG8_WAIT_L(0); PG8_MMA(0, 1, At, B1); PG8_BAR;
            PG8_LDA(At, 1, 1); PG8_STAGE(PG8_SA(1, 0), a3, voffA);
            PG8_BAR; PG8_WAIT_L(0); PG8_MMA(1, 0, At, B0); PG8_BAR; PG8_SCHED;
            PG8_STAGE(PG8_SB(1, 1), b3 + hstep, voffB);
            PG8_WAIT_V(6); PG8_BAR; PG8_MMA(1, 1, At, B1); PG8_BAR;
            }
        }
        if constexpr (ALIGN_EPI) { if (wr == 0) PG8_BAR; }
        if constexpr (!Epi::AFTER_DRAIN) { E(acc, cur, wr, wc, fr, fq); S.done(cur); }
        if (!has_next) break;
#pragma unroll
        for (int a = 0; a < 2; ++a)
#pragma unroll
            for (int b = 0; b < 2; ++b)
#pragma unroll
                for (int m = 0; m < 4; ++m)
#pragma unroll
                    for (int n = 0; n < 2; ++n) acc[a][b][m][n] = (f32x4){0.f, 0.f, 0.f, 0.f};
        cur = nxt; cA = nA; cB = nB; ++ui;
        if constexpr (ALIGN_EPI) { if (wr == 1) PG8_BAR; }
    }
    PG8_WAIT_V(0);
    if constexpr (!ALIGN_EPI) { if (wr == 0) PG8_BAR; }
    PG8_BAR;
    if constexpr (Epi::AFTER_DRAIN) { E.fused(acc, cur, wr, wc, fr, fq, lds, wid, lane); S.done(cur); }
#undef PG8_SA
#undef PG8_SB
#undef PG8_STAGE
#undef PG8_LDA
#undef PG8_LDB
#undef PG8_MMA
#undef PG8_WAIT_V
#undef PG8_WAIT_L
#undef PG8_BAR
#undef PG8_SCHED
}
}

constexpr int DM = 1024, NB = 8, SEQ = 2048, DB = 16, DSEQ = 64, PAST = 2048;
constexpr int MP = NB * SEQ, MS = DB * DSEQ, MT = MP + MS;
constexpr int NIN = 3072, DFF = 4096, NMOD = 6 * DM;
constexpr float EPS = 1e-6f;
constexpr float LOG2E = 1.4426950408889634f;
constexpr size_t O_KVP = (size_t)MT * DM;
constexpr size_t KVP_SZ = (size_t)MP * 512;
constexpr size_t O_KVS = O_KVP + 4 * KVP_SZ;
constexpr size_t KVS_SZ = (size_t)MS * 512;
constexpr size_t MiB = 1u << 20;
constexpr size_t WS_CTL = 0, WS_MOD = 1 * MiB, WS_WIN = 2 * MiB, WS_WOUT = 8 * MiB, WS_WUP = 10 * MiB, WS_WDN = 18 * MiB;
constexpr size_t WS_XN = 26 * MiB, WS_U = 60 * MiB, WS_MIX = 162 * MiB, WS_HB = 60 * MiB, WS_Y = 196 * MiB, WS_END = 264 * MiB;
static_assert(WS_XN + (size_t)MT * DM * 2 <= WS_U && WS_U + (size_t)MT * NIN * 2 <= WS_MIX && WS_MIX + (size_t)MT * DM * 2 <= WS_Y && WS_HB + (size_t)MT * DFF * 2 <= WS_Y && WS_Y + (size_t)MT * DM * 4 <= WS_END, "ws map");
constexpr int LDS_BYTES = 131072 + 1024;
constexpr int LDS_MISC = 131072;

#define LAS __attribute__((address_space(3)))
#define DI __device__ __forceinline__
typedef unsigned short bf16_t;
typedef short bf16x8 __attribute__((ext_vector_type(8)));
typedef short s16x4 __attribute__((ext_vector_type(4)));
typedef float f32x4 __attribute__((ext_vector_type(4)));
typedef float f32x16 __attribute__((ext_vector_type(16)));
typedef unsigned u32x4 __attribute__((ext_vector_type(4)));
typedef unsigned u32x2 __attribute__((ext_vector_type(2)));
typedef float f32x2_t __attribute__((ext_vector_type(2)));
typedef __bf16 bf16x2_t __attribute__((ext_vector_type(2)));
DI unsigned cvtpk(float lo, float hi) { f32x2_t v = {lo, hi}; bf16x2_t b = __builtin_convertvector(v, bf16x2_t); return __builtin_bit_cast(unsigned, b); }
#define LDS_WAIT() asm volatile("s_waitcnt lgkmcnt(0)" ::: "memory")

namespace pg8 {
struct EpiQKV {
    static constexpr bool PERM = true, AFTER_DRAIN = false;
    bf16_t* U; float* out;
    __device__ __forceinline__ void operator()(const f32x4 (&acc)[2][2][4][2], const Unit& u, int wr, int wc, int fr, int fq) const {
        const int sec = u.pn >> 1;
        const bool kv = (sec == 1) || (sec == 2) || (sec == 4) || (sec == 5);
        const int kvi = (sec == 1) ? 0 : (sec == 2) ? 1 : (sec == 4) ? 2 : 3;
        const bool prompt = u.pm < (MP / BM);
        float* fbase = prompt ? out + O_KVP + (size_t)kvi * KVP_SZ : out + O_KVS + (size_t)kvi * KVS_SZ - (size_t)MP * 512;
        const int row0 = u.pm * BM + wr * 64 + fr, col0 = u.pn * BM + wc * 32 + 8 * fq, colsec = col0 - sec * 512;
#pragma unroll
        for (int ai = 0; ai < 2; ++ai)
#pragma unroll
            for (int m = 0; m < 4; ++m) { const int row = row0 + ai * HALF + m * 16;
#pragma unroll
                for (int bj = 0; bj < 2; ++bj) { const f32x4 v0 = acc[ai][bj][m][0], v1 = acc[ai][bj][m][1];
                    u32x4 w; w.x = cvt_pk_bf16(v0[0], v0[1]); w.y = cvt_pk_bf16(v0[2], v0[3]); w.z = cvt_pk_bf16(v1[0], v1[1]); w.w = cvt_pk_bf16(v1[2], v1[3]);
                    *(u32x4*)(U + (size_t)row * NIN + col0 + bj * HALF) = w;
                    if (kv) { float* d = fbase + (size_t)row * 512 + colsec + bj * HALF; *(f32x4*)d = v0; *(f32x4*)(d + 4) = v1; } } }
    }
};
struct EpiF32 {
    static constexpr bool PERM = true, AFTER_DRAIN = false;
    float* Y; int ldc;
    __device__ __forceinline__ void operator()(const f32x4 (&acc)[2][2][4][2], const Unit& u, int wr, int wc, int fr, int fq) const {
        const int row0 = u.pm * BM + wr * 64 + fr, col0 = u.pn * BM + wc * 32 + 8 * fq;
#pragma unroll
        for (int ai = 0; ai < 2; ++ai)
#pragma unroll
            for (int m = 0; m < 4; ++m) { float* rowp = Y + (size_t)(row0 + ai * HALF + m * 16) * ldc + col0;
#pragma unroll
                for (int bj = 0; bj < 2; ++bj) { *(f32x4*)(rowp + bj * HALF) = acc[ai][bj][m][0]; *(f32x4*)(rowp + bj * HALF + 4) = acc[ai][bj][m][1]; } }
    }
};
struct EpiRelu2 {
    static constexpr bool PERM = true, AFTER_DRAIN = false;
    bf16_t* O; int ldc;
    __device__ __forceinline__ void operator()(const f32x4 (&acc)[2][2][4][2], const Unit& u, int wr, int wc, int fr, int fq) const {
        const int row0 = u.pm * BM + wr * 64 + fr, col0 = u.pn * BM + wc * 32 + 8 * fq;
#pragma unroll
        for (int ai = 0; ai < 2; ++ai)
#pragma unroll
            for (int m = 0; m < 4; ++m) { bf16_t* rowp = O + (size_t)(row0 + ai * HALF + m * 16) * ldc + col0;
#pragma unroll
                for (int bj = 0; bj < 2; ++bj) { f32x4 v0 = acc[ai][bj][m][0], v1 = acc[ai][bj][m][1];
                    v0 = __builtin_elementwise_max(v0, (f32x4){0.f, 0.f, 0.f, 0.f}); v1 = __builtin_elementwise_max(v1, (f32x4){0.f, 0.f, 0.f, 0.f}); v0 = v0 * v0; v1 = v1 * v1;
                    u32x4 w; w.x = cvt_pk_bf16(v0[0], v0[1]); w.y = cvt_pk_bf16(v0[2], v0[3]); w.z = cvt_pk_bf16(v1[0], v1[1]); w.w = cvt_pk_bf16(v1[2], v1[3]);
                    *(u32x4*)(rowp + bj * HALF) = w; } }
    }
};
}

DI float wave_sum(float v) {
#pragma unroll
    for (int o = 1; o < 64; o <<= 1) v += __shfl_xor(v, o);
    return v;
}
DI unsigned f2bf(float f) { unsigned u = __builtin_bit_cast(unsigned, f); return (u + 0x7fffu + ((u >> 16) & 1u)) >> 16; }
DI unsigned pk2(float lo, float hi) { return f2bf(lo) | (f2bf(hi) << 16); }
DI float xswap_add(float v) { auto rr = __builtin_amdgcn_permlane32_swap(__float_as_uint(v), __float_as_uint(v), false, false); return __uint_as_float(rr[0]) + __uint_as_float(rr[1]); }
DI float xswap_max(float v) { auto rr = __builtin_amdgcn_permlane32_swap(__float_as_uint(v), __float_as_uint(v), false, false); return fmaxf(__uint_as_float(rr[0]), __uint_as_float(rr[1])); }

DI void p0_transpose_item(const float* W, int K, int N, bf16_t* WT, LAS float* scr, int item, int lane) {
    const int nblk = N / 32, kb = item / nblk, nb = item % nblk, k0 = 64 * kb, n0 = 32 * nb;
#pragma unroll 8
    for (int i = 0; i < 32; ++i) { const int kk = 2 * i + (lane >> 5); scr[kk * 33 + (lane & 31)] = W[(size_t)(k0 + kk) * N + n0 + (lane & 31)]; }
    LDS_WAIT();
    const int c = lane & 7;
#pragma unroll
    for (int j = 0; j < 4; ++j) { const int n = (lane >> 3) + 8 * j; const LAS float* s = scr + (8 * c) * 33 + n;
        u32x4 o; o.x = pk2(s[0 * 33], s[1 * 33]); o.y = pk2(s[2 * 33], s[3 * 33]); o.z = pk2(s[4 * 33], s[5 * 33]); o.w = pk2(s[6 * 33], s[7 * 33]);
        *(u32x4*)(WT + (size_t)(n0 + n) * K + k0 + 8 * c) = o; }
    LDS_WAIT();
}
DI void p0_modulate_item(const float* cp, const float* cs, const float* w_ada, const float* b_ada, float* mod, LAS float* scr, int item, int lane) {
    const int col = item * 32 + (lane & 31), kh = lane >> 5;
    float acc[24];
#pragma unroll
    for (int bi = 0; bi < 24; ++bi) acc[bi] = 0.f;
    for (int ch = 0; ch < 8; ++ch) {
        for (int e = lane; e < 24 * 128; e += 64) { const int bi = e >> 7, j = e & 127;
            const float v = (bi < 8) ? cp[bi * DM + 128 * ch + j] : cs[(bi - 8) * DM + 128 * ch + j];
            scr[e] = v / (1.f + __expf(-v)); }
        LDS_WAIT();
#pragma unroll 4
        for (int i = 0; i < 64; ++i) { const int kk = 2 * i + kh; const float wv = w_ada[(size_t)(128 * ch + kk) * NMOD + col];
#pragma unroll
            for (int bi = 0; bi < 24; ++bi) acc[bi] += scr[bi * 128 + kk] * wv; }
        LDS_WAIT();
    }
#pragma unroll
    for (int bi = 0; bi < 24; ++bi) acc[bi] += __shfl_xor(acc[bi], 32);
    if (lane < 32) { const float bb = b_ada[col];
#pragma unroll
        for (int bi = 0; bi < 24; ++bi) mod[bi * NMOD + col] = acc[bi] + bb; }
}

DI int row_bi(int row) { return row < MP ? (row >> 11) : 8 + ((row - MP) >> 6); }
DI void p1_row(const float* xrow, const float* mod, const float* g, bf16_t* orow, int bi, int lane) {
    const f32x4* xr = (const f32x4*)xrow + lane; f32x4 v[4]; float s = 0.f;
#pragma unroll
    for (int j = 0; j < 4; ++j) { v[j] = xr[64 * j]; s += (v[j].x * v[j].x + v[j].y * v[j].y) + (v[j].z * v[j].z + v[j].w * v[j].w); }
    const float r = rsqrtf(wave_sum(s) * (1.f / DM) + EPS);
    const f32x4* gg = (const f32x4*)g + lane; const f32x4* sh = (const f32x4*)(mod + (size_t)bi * NMOD) + lane; const f32x4* sc = (const f32x4*)(mod + (size_t)bi * NMOD + DM) + lane;
    u32x2* o8 = (u32x2*)orow + lane;
#pragma unroll
    for (int j = 0; j < 4; ++j) { const f32x4 h = v[j] * r * gg[64 * j] * (sc[64 * j] + 1.f) + sh[64 * j]; u32x2 w; w.x = cvtpk(h.x, h.y); w.y = cvtpk(h.z, h.w); o8[64 * j] = w; }
}
DI void p5_row(const float* xrow, const float* yrow, const float* mod, const float* gpost, const float* gpre2, float* outrow, bf16_t* xnrow, int bi, int lane) {
    const f32x4* xr = (const f32x4*)xrow + lane; const f32x4* yr = (const f32x4*)yrow + lane; f32x4 y[4], x1[4]; float s = 0.f;
#pragma unroll
    for (int j = 0; j < 4; ++j) { y[j] = yr[64 * j]; s += (y[j].x * y[j].x + y[j].y * y[j].y) + (y[j].z * y[j].z + y[j].w * y[j].w); }
    const float r1 = rsqrtf(wave_sum(s) * (1.f / DM) + EPS);
    const float* mb = mod + (size_t)bi * NMOD;
    const f32x4* gp = (const f32x4*)gpost + lane; const f32x4* ga = (const f32x4*)(mb + 2 * DM) + lane;
    float s2 = 0.f; f32x4* orow = (f32x4*)outrow + lane;
#pragma unroll
    for (int j = 0; j < 4; ++j) { x1[j] = xr[64 * j] + ga[64 * j] * (y[j] * r1 * gp[64 * j]); orow[64 * j] = x1[j];
        s2 += (x1[j].x * x1[j].x + x1[j].y * x1[j].y) + (x1[j].z * x1[j].z + x1[j].w * x1[j].w); }
    const float r2 = rsqrtf(wave_sum(s2) * (1.f / DM) + EPS);
    const f32x4* g2 = (const f32x4*)gpre2 + lane; const f32x4* sh = (const f32x4*)(mb + 3 * DM) + lane; const f32x4* sc = (const f32x4*)(mb + 4 * DM) + lane;
    u32x2* o8 = (u32x2*)xnrow + lane;
#pragma unroll
    for (int j = 0; j < 4; ++j) { const f32x4 h = x1[j] * r2 * g2[64 * j] * (sc[64 * j] + 1.f) + sh[64 * j]; u32x2 w; w.x = cvtpk(h.x, h.y); w.y = cvtpk(h.z, h.w); o8[64 * j] = w; }
}
DI void p8_row(const float* yrow, const float* mod, const float* gpost, float* outrow, int bi, int lane) {
    const f32x4* yr = (const f32x4*)yrow + lane; f32x4 y[4]; float s = 0.f;
#pragma unroll
    for (int j = 0; j < 4; ++j) { y[j] = yr[64 * j]; s += (y[j].x * y[j].x + y[j].y * y[j].y) + (y[j].z * y[j].z + y[j].w * y[j].w); }
    const float r1 = rsqrtf(wave_sum(s) * (1.f / DM) + EPS);
    const f32x4* gp = (const f32x4*)gpost + lane; const f32x4* ga = (const f32x4*)(mod + (size_t)bi * NMOD + 5 * DM) + lane; f32x4* orow = (f32x4*)outrow + lane;
#pragma unroll
    for (int j = 0; j < 4; ++j) orow[64 * j] = orow[64 * j] + ga[64 * j] * (y[j] * r1 * gp[64 * j]);
}

namespace att {
#define MFMA32(a, b, c) __builtin_amdgcn_mfma_f32_32x32x16_bf16((a), (b), (c), 0, 0, 0)
typedef short v4i16_t __attribute__((ext_vector_type(4)));
DI unsigned off_b(unsigned row, unsigned ch) { return 256u * row + 16u * (ch ^ (((row & 3u) << 2) | ((row >> 2) & 3u))); }
DI s16x4 trr(const LAS char* p) { return __builtin_bit_cast(s16x4, __builtin_amdgcn_ds_read_tr16_b64_v4i16((LAS v4i16_t*)p)); }
DI bf16x8 cat8(s16x4 lo, s16x4 hi) { return (bf16x8){lo[0], lo[1], lo[2], lo[3], hi[0], hi[1], hi[2], hi[3]}; }
template <int S> DI bf16x8 pack8(const f32x16& x) { u32x4 p; p[0] = cvtpk(x[8 * S], x[8 * S + 1]); p[1] = cvtpk(x[8 * S + 2], x[8 * S + 3]); p[2] = cvtpk(x[8 * S + 4], x[8 * S + 5]); p[3] = cvtpk(x[8 * S + 6], x[8 * S + 7]); return __builtin_bit_cast(bf16x8, p); }
DI u32x4 cvt8(u32x4 a, u32x4 b) {
    u32x4 o; o.x = cvtpk(__uint_as_float(a.x), __uint_as_float(a.y)); o.y = cvtpk(__uint_as_float(a.z), __uint_as_float(a.w));
    o.z = cvtpk(__uint_as_float(b.x), __uint_as_float(b.y)); o.w = cvtpk(__uint_as_float(b.z), __uint_as_float(b.w)); return o; }

struct Ctx {
    const bf16_t* U; bf16_t* MIX;
    const float *cdk, *cdv, *csk, *csv;
    const float* subg; float lam;
};

DI void diff_unit(const Ctx& C, LAS char* lds, bool sample, int b, int hh, int u) {
    int tid_ = threadIdx.x; asm volatile("" : "+v"(tid_));
    const int tid = tid_, lane = tid & 63, r = lane & 31, h = lane >> 5, w = __builtin_amdgcn_readfirstlane(tid >> 6);
    const int qblk = w >> 1, map = w & 1;
    const bool active = sample ? (w < 4) : true;
    const int ncache = sample ? 32 : 0;
    const int tokbase = sample ? MP + b * DSEQ : b * SEQ;
    const int cbase = b * PAST;
    const int Tmax = sample ? 32 : 2 * u + 1;
    const int qrel = sample ? 32 * qblk : 128 * u + 32 * qblk;
    const int Tw = sample ? 32 : (qrel >> 6);
    const int qpos = (sample ? PAST : 0) + qrel + r;
    const int qrow = tokbase + (active ? qrel : 0) + r;
    bf16x8 qf[4];
#pragma unroll
    for (int ds = 0; ds < 4; ++ds) qf[ds] = *(const bf16x8*)(C.U + (size_t)qrow * NIN + hh * 128 + map * 64 + 16 * ds + 8 * h);
    unsigned kaddr[4];
    { const unsigned x = ((r & 3u) << 2) | ((r >> 2) & 3u);
#pragma unroll
      for (int ds = 0; ds < 4; ++ds) kaddr[ds] = 256u * r + 16u * ((unsigned)(2 * (4 * map + ds) + h) ^ x); }
    unsigned vaddr[2][4];
    { const unsigned blk = (lane >> 4) & 1, q = (lane & 15) >> 2, p = lane & 3;
#pragma unroll
      for (int t = 0; t < 2; ++t)
#pragma unroll
          for (int c = 0; c < 4; ++c) vaddr[t][c] = off_b(8 * t + 4 * h + q, 4 * c + 2 * blk + (p >> 1)) + 8 * (p & 1); }
    const int srow = tid >> 4, sch = tid & 15;
    const unsigned sdst0 = off_b(srow, sch), sdst1 = off_b(srow + 32, sch);
    u32x4 st[4];
    auto issue = [&](int t, int isv) {
        if (t < ncache) {
            const float* src = isv ? C.cdv : C.cdk;
            const size_t o0 = (size_t)(cbase + 64 * t + srow) * 512 + hh * 128 + sch * 8, o1 = o0 + (size_t)32 * 512;
            st[0] = *(const u32x4*)(src + o0); st[1] = *(const u32x4*)(src + o0 + 4); st[2] = *(const u32x4*)(src + o1); st[3] = *(const u32x4*)(src + o1 + 4);
        } else {
            const bf16_t* g0 = C.U + (size_t)(tokbase + 64 * (t - ncache) + srow) * NIN + hh * 128 + sch * 8 + (isv ? 1024 : 512);
            st[0] = *(const u32x4*)g0; st[1] = *(const u32x4*)(g0 + (size_t)32 * NIN);
        }
    };
    auto commit = [&](int t, int buf, int isv) {
        LAS char* img = lds + buf * 32768 + (isv ? 16384 : 0);
        if (t < ncache) { *(LAS u32x4*)(img + sdst0) = cvt8(st[0], st[1]); *(LAS u32x4*)(img + sdst1) = cvt8(st[2], st[3]); }
        else { *(LAS u32x4*)(img + sdst0) = st[0]; *(LAS u32x4*)(img + sdst1) = st[1]; }
    };
    const float slope = __builtin_amdgcn_exp2f(-2.f * (float)(hh + 1));
    const float c1 = 0.125f * LOG2E, sl2 = slope * LOG2E;
    f32x16 o[4];
#pragma unroll
    for (int dt = 0; dt < 4; ++dt)
#pragma unroll
        for (int i = 0; i < 16; ++i) o[dt][i] = 0.f;
    float mrun = -1e30f, lrun = 0.f;

    issue(Tmax, 0); commit(Tmax, 0, 0); issue(Tmax, 1); commit(Tmax, 0, 1); __syncthreads();
    int cur = 0;
    for (int t = Tmax; t >= 0; --t) {
        const bool comp = active && t <= Tw;
        const LAS char* kimg = lds + cur * 32768; const LAS char* vimg = kimg + 16384;
        bf16x8 P[4];
        if (t > 0) issue(t - 1, 0);
        if (comp) {
            f32x16 s0, s1;
#pragma unroll
            for (int i = 0; i < 16; ++i) { s0[i] = 0.f; s1[i] = 0.f; }
#pragma unroll
            for (int ds = 0; ds < 4; ++ds) {
                const bf16x8 k0 = *(const LAS bf16x8*)(kimg + kaddr[ds]); const bf16x8 k1 = *(const LAS bf16x8*)(kimg + kaddr[ds] + 8192);
                s0 = MFMA32(k0, qf[ds], s0); s1 = MFMA32(k1, qf[ds], s1); }
            const float d0 = (float)(qpos - 64 * t - 4 * h);
            float mx = -1e30f;
#pragma unroll
            for (int i = 0; i < 16; ++i) { const float ci = (float)((i & 3) + 8 * (i >> 2));
                s0[i] = s0[i] * c1 - sl2 * fabsf(d0 - ci); s1[i] = s1[i] * c1 - sl2 * fabsf(d0 - 32.f - ci);
                mx = fmaxf(mx, fmaxf(s0[i], s1[i])); }
            mx = xswap_max(mx);
            const float mnew = fmaxf(mrun, mx);
            if (__any(mnew > mrun)) { const float alpha = __builtin_amdgcn_exp2f(mrun - mnew); lrun *= alpha; mrun = mnew;
#pragma unroll
                for (int dt = 0; dt < 4; ++dt)
#pragma unroll
                    for (int i = 0; i < 16; ++i) o[dt][i] *= alpha; }
            float ps = 0.f;
#pragma unroll
            for (int i = 0; i < 16; ++i) { s0[i] = __builtin_amdgcn_exp2f(s0[i] - mrun); s1[i] = __builtin_amdgcn_exp2f(s1[i] - mrun); ps += s0[i] + s1[i]; }
            lrun += ps;
            P[0] = pack8<0>(s0); P[1] = pack8<1>(s0); P[2] = pack8<0>(s1); P[3] = pack8<1>(s1);
        }
        if (t > 0) { commit(t - 1, cur ^ 1, 0); issue(t - 1, 1); }
        if (comp) {
#pragma unroll
            for (int dt = 0; dt < 4; ++dt)
#pragma unroll
                for (int ks = 0; ks < 4; ++ks) { const s16x4 lo = trr(vimg + vaddr[0][dt] + 4096 * ks), hi = trr(vimg + vaddr[1][dt] + 4096 * ks);
                    o[dt] = MFMA32(cat8(lo, hi), P[ks], o[dt]); }
        }
        if (t > 0) commit(t - 1, cur ^ 1, 1);
        __syncthreads();
        cur ^= 1;
    }
    const float inv = 1.f / xswap_add(lrun);
    LAS float* X = (LAS float*)(lds + (w >> 1) * 16384);
    if (active && map == 1) { const float f = C.lam * inv;
#pragma unroll
        for (int dt = 0; dt < 4; ++dt)
#pragma unroll
            for (int i = 0; i < 16; ++i) X[(dt * 16 + i) * 64 + lane] = o[dt][i] * f; }
    __syncthreads();
    if (active && map == 0) { float ss = 0.f;
#pragma unroll
        for (int dt = 0; dt < 4; ++dt)
#pragma unroll
            for (int i = 0; i < 16; ++i) { const float v = o[dt][i] * inv - X[(dt * 16 + i) * 64 + lane]; o[dt][i] = v; ss += v * v; }
        ss = xswap_add(ss);
        const float rn = rsqrtf(ss * (1.f / 128.f) + EPS) * 0.8f;
        bf16_t* orow = C.MIX + (size_t)qrow * DM + hh * 128;
#pragma unroll
        for (int dt = 0; dt < 4; ++dt)
#pragma unroll
            for (int g = 0; g < 4; ++g) { const int d = 32 * dt + 8 * g + 4 * h; const f32x4 gg = *(const f32x4*)(C.subg + d);
                u32x2 wv; wv.x = cvtpk(o[dt][4 * g] * rn * gg.x, o[dt][4 * g + 1] * rn * gg.y); wv.y = cvtpk(o[dt][4 * g + 2] * rn * gg.z, o[dt][4 * g + 3] * rn * gg.w);
                *(u32x2*)(orow + d) = wv; } }
    __syncthreads();
}

constexpr float SB_THR = -200.f;
DI void sb_unit(const Ctx& C, LAS char* lds, bool sample, int b, int hh, int qb) {
    int tid_ = threadIdx.x; asm volatile("" : "+v"(tid_));
    const int tid = tid_, lane = tid & 63, r = lane & 31, h = lane >> 5, w = __builtin_amdgcn_readfirstlane(tid >> 6);
    const bool active = sample ? (w < 2) : true;
    const int ncache = sample ? 32 : 0;
    const int tokbase = sample ? MP + b * DSEQ : b * SEQ;
    const int cbase = b * PAST;
    const int Tmax = sample ? 32 : 4 * qb + 3;
    const int qrel = sample ? 32 * w : 256 * qb + 32 * w;
    const int Tw = sample ? 32 : (qrel >> 6);
    const int qi = (qrel & 63) + r;
    const int qrow = tokbase + (active ? qrel : 0) + r;
    LAS unsigned* flags = (LAS unsigned*)(lds + 32768);
    bf16x8 qf[4];
#pragma unroll
    for (int ds = 0; ds < 4; ++ds) qf[ds] = *(const bf16x8*)(C.U + (size_t)qrow * NIN + 1536 + hh * 64 + 16 * ds + 8 * h);
    unsigned kaddr[4];
    { const unsigned x = ((r & 3u) << 2) | ((r >> 2) & 3u);
#pragma unroll
      for (int ds = 0; ds < 4; ++ds) kaddr[ds] = 256u * r + 16u * ((unsigned)(2 * ds + h) ^ x); }
    unsigned vaddr[2][2];
    { const unsigned blk = (lane >> 4) & 1, q = (lane & 15) >> 2, p = lane & 3;
#pragma unroll
      for (int t = 0; t < 2; ++t)
#pragma unroll
          for (int c = 0; c < 2; ++c) vaddr[t][c] = off_b(8 * t + 4 * h + q, 4 * (c + 2) + 2 * blk + (p >> 1)) + 8 * (p & 1); }
    bf16x8 tri[2];
#pragma unroll
    for (int s = 0; s < 2; ++s)
#pragma unroll
        for (int j = 0; j < 8; ++j) tri[s][j] = ((16 * s + 8 * (j >> 2) + 4 * h + (j & 3)) > r) ? (short)0x3F80 : (short)0;
    const int srow = tid >> 4, sch = tid & 15;
    const unsigned sdst0 = off_b(srow, sch), sdst1 = off_b(srow + 32, sch);
    const int scol = (sch < 8) ? (2048 + hh * 64 + sch * 8) : (2560 + hh * 64 + (sch - 8) * 8);
    const float* csrc = (sch < 8) ? C.csk : C.csv;
    u32x4 st[4];
    auto issue = [&](int t) {
        if (t < ncache) {
            const size_t o0 = (size_t)(cbase + 64 * t + srow) * 512 + hh * 64 + (sch & 7) * 8, o1 = o0 + (size_t)32 * 512;
            st[0] = *(const u32x4*)(csrc + o0); st[1] = *(const u32x4*)(csrc + o0 + 4); st[2] = *(const u32x4*)(csrc + o1); st[3] = *(const u32x4*)(csrc + o1 + 4);
        } else {
            const bf16_t* g0 = C.U + (size_t)(tokbase + 64 * (t - ncache) + srow) * NIN + scol;
            st[0] = *(const u32x4*)g0; st[1] = *(const u32x4*)(g0 + (size_t)32 * NIN);
        }
    };
    auto commit = [&](int t, int buf) {
        LAS char* img = lds + buf * 16384;
        if (t < ncache) { *(LAS u32x4*)(img + sdst0) = cvt8(st[0], st[1]); *(LAS u32x4*)(img + sdst1) = cvt8(st[2], st[3]); }
        else { *(LAS u32x4*)(img + sdst0) = st[0]; *(LAS u32x4*)(img + sdst1) = st[1]; }
    };
    const float c1 = 0.125f * LOG2E;
    f32x16 o[2];
#pragma unroll
    for (int dt = 0; dt < 2; ++dt)
#pragma unroll
        for (int i = 0; i < 16; ++i) o[dt][i] = 0.f;
    float R = 0.f;

    issue(Tmax); commit(Tmax, 0); __syncthreads();
    int cur = 0;
    for (int t = Tmax; t >= 0; --t) {
        if (t > 0) issue(t - 1);
        unsigned done = active ? 0u : 1u;
        if (active && t <= Tw) {
            const LAS char* img = lds + cur * 16384;
            const bool diag = (t == Tw);
            bf16x8 P[4];
            float carry = R;
            float tsum = 0.f;
#define SB_HALF(KT) { \
                f32x16 z; _Pragma("unroll") for (int i = 0; i < 16; ++i) z[i] = 0.f; \
                _Pragma("unroll") for (int ds = 0; ds < 4; ++ds) { const bf16x8 kf = *(const LAS bf16x8*)(img + kaddr[ds] + 8192 * (KT)); z = MFMA32(kf, qf[ds], z); } \
                f32x16 ln, hi_f; float sm = 0.f; \
                _Pragma("unroll") for (int i = 0; i < 16; ++i) { const float z2 = z[i] * c1; const float e = __builtin_amdgcn_exp2f(-fabsf(z2)); \
                    const float sp = fmaxf(z2, 0.f) + __builtin_amdgcn_logf(1.f + e); \
                    const bool earlier = !diag || ((32 * (KT) + (i & 3) + 8 * (i >> 2) + 4 * h) < qi); \
                    ln[i] = earlier ? -sp : 0.f; z[i] = earlier ? (z2 - sp) : -1e30f; sm += ln[i]; } \
                sm = xswap_add(sm); \
                u32x4 ph0, ph1, pl0, pl1; \
                _Pragma("unroll") for (int k2 = 0; k2 < 4; ++k2) { \
                    const unsigned a = cvtpk(ln[2 * k2], ln[2 * k2 + 1]); ph0[k2] = a; pl0[k2] = cvtpk(ln[2 * k2] - __uint_as_float(a << 16), ln[2 * k2 + 1] - __uint_as_float(a & 0xffff0000u)); \
                    const unsigned bq = cvtpk(ln[8 + 2 * k2], ln[9 + 2 * k2]); ph1[k2] = bq; pl1[k2] = cvtpk(ln[8 + 2 * k2] - __uint_as_float(bq << 16), ln[9 + 2 * k2] - __uint_as_float(bq & 0xffff0000u)); } \
                f32x16 bt; _Pragma("unroll") for (int i = 0; i < 16; ++i) bt[i] = carry; \
                bt = MFMA32(tri[0], __builtin_bit_cast(bf16x8, ph0), bt); bt = MFMA32(tri[1], __builtin_bit_cast(bf16x8, ph1), bt); \
                bt = MFMA32(tri[0], __builtin_bit_cast(bf16x8, pl0), bt); bt = MFMA32(tri[1], __builtin_bit_cast(bf16x8, pl1), bt); \
                _Pragma("unroll") for (int i = 0; i < 16; ++i) z[i] = __builtin_amdgcn_exp2f(z[i] + bt[i]); \
                P[2 * (KT)] = pack8<0>(z); P[2 * (KT) + 1] = pack8<1>(z); \
                carry += sm; tsum += sm; }
            SB_HALF(1)
            SB_HALF(0)
#undef SB_HALF
            R += tsum;
#pragma unroll
            for (int dt = 0; dt < 2; ++dt)
#pragma unroll
                for (int ks = 0; ks < 4; ++ks) { const s16x4 lo = trr(img + vaddr[0][dt] + 4096 * ks), hi = trr(img + vaddr[1][dt] + 4096 * ks);
                    o[dt] = MFMA32(cat8(lo, hi), P[ks], o[dt]); }
            done = __all(R < SB_THR) ? 1u : 0u;
        }
        if (lane == 0) flags[(cur << 3) + w] = done;
        if (t > 0) commit(t - 1, cur ^ 1);
        __syncthreads();
        bool alld = true;
#pragma unroll
        for (int k = 0; k < 8; ++k) alld = alld && (flags[(cur << 3) + k] != 0u);
        cur ^= 1;
        if (alld) break;
    }
    if (active) {
        bf16_t* orow = C.MIX + (size_t)qrow * DM + 512 + hh * 64;
#pragma unroll
        for (int dt = 0; dt < 2; ++dt)
#pragma unroll
            for (int g = 0; g < 4; ++g) { const int d = 32 * dt + 8 * g + 4 * h;
                u32x2 wv; wv.x = cvtpk(o[dt][4 * g], o[dt][4 * g + 1]); wv.y = cvtpk(o[dt][4 * g + 2], o[dt][4 * g + 3]);
                *(u32x2*)(orow + d) = wv; }
    }
    __syncthreads();
}
constexpr int N_DS = 64, N_DP = 512, N_SP = 512, N_SS = 128, N_UNITS = N_DS + N_DP + N_SP + N_SS;
}

struct Params { const float* in[23]; float* out; unsigned char* ws; };

__global__ void __launch_bounds__(512, 2) fwd_megakernel(Params p) {
    extern __shared__ __attribute__((aligned(16))) unsigned char lds_raw[];
    cg::grid_group grid = cg::this_grid();
    LAS unsigned char* lds = (LAS unsigned char*)lds_raw;
    const int tid = threadIdx.x, lane = tid & 63, wave = __builtin_amdgcn_readfirstlane(tid >> 6);
    const int G = gridDim.x, NGW = G * 8, gw = wave * G + (int)blockIdx.x;
    unsigned char* ws = p.ws;
    unsigned* ctl = (unsigned*)(ws + WS_CTL);
    float* mod = (float*)(ws + WS_MOD);
    bf16_t* Win_t = (bf16_t*)(ws + WS_WIN); bf16_t* Wout_t = (bf16_t*)(ws + WS_WOUT); bf16_t* Wup_t = (bf16_t*)(ws + WS_WUP); bf16_t* Wdn_t = (bf16_t*)(ws + WS_WDN);
    bf16_t* XN = (bf16_t*)(ws + WS_XN); bf16_t* U = (bf16_t*)(ws + WS_U); bf16_t* MIX = (bf16_t*)(ws + WS_MIX); bf16_t* HB = (bf16_t*)(ws + WS_HB);
    float* Y = (float*)(ws + WS_Y);
    const float* xp = p.in[0]; const float* xs = p.in[1];

    {
        if (blockIdx.x == 0 && tid == 0) ctl[0] = 0u;
        LAS float* scr = (LAS float*)(lds + wave * 16384);
        constexpr int I_MOD = NMOD / 32, I_IN = (DM / 64) * (NIN / 32), I_OUT = (DM / 64) * (DM / 32), I_UP = (DM / 64) * (DFF / 32), I_DN = (DFF / 64) * (DM / 32);
        constexpr int NITEMS = I_MOD + I_IN + I_OUT + I_UP + I_DN;
        for (int it = gw; it < NITEMS; it += NGW) {
            int r = it;
            if (r < I_MOD) { p0_modulate_item(p.in[2], p.in[3], p.in[8], p.in[9], mod, scr, r, lane); continue; } r -= I_MOD;
            if (r < I_IN) { p0_transpose_item(p.in[12], DM, NIN, Win_t, scr, r, lane); continue; } r -= I_IN;
            if (r < I_OUT) { p0_transpose_item(p.in[18], DM, DM, Wout_t, scr, r, lane); continue; } r -= I_OUT;
            if (r < I_UP) { p0_transpose_item(p.in[21], DM, DFF, Wup_t, scr, r, lane); continue; } r -= I_UP;
            p0_transpose_item(p.in[22], DFF, DM, Wdn_t, scr, r, lane);
        }
    }
    grid.sync();
    for (int row = gw; row < MT; row += NGW) {
        const float* xr = row < MP ? xp + (size_t)row * DM : xs + (size_t)(row - MP) * DM;
        p1_row(xr, mod, p.in[10], XN + (size_t)row * DM, row_bi(row), lane);
    }
    grid.sync();
    {
        pg8::Gemm g{XN, Win_t, MT, NIN, DM}; pg8::StaticOrder S; S.init(MT, NIN, G, (int)blockIdx.x);
        pg8::EpiQKV E{U, p.out};
        pg8::gemm_phase<pg8::EpiQKV, pg8::StaticOrder, true, true>(lds, g, S, E);
    }
    grid.sync();
#ifndef NO_ATT
    {
        att::Ctx C; C.U = U; C.MIX = MIX; C.cdk = p.in[4]; C.cdv = p.in[5]; C.csk = p.in[6]; C.csv = p.in[7]; C.subg = p.in[17];
        { const float a = p.in[13][lane] * p.in[14][lane], bq = p.in[15][lane] * p.in[16][lane];
          C.lam = __expf(wave_sum(a)) - __expf(wave_sum(bq)) + 0.2f; }
        LAS unsigned* qword = (LAS unsigned*)(lds + LDS_MISC);
        for (;;) {
            if (tid == 0) qword[0] = atomicAdd(ctl, 1u);
            __syncthreads();
            const int idx = (int)qword[0];
            __syncthreads();
            if (idx >= att::N_UNITS) break;
            bool is_diff, sample; int ub, uh, uu;
            if (idx < att::N_DS) { is_diff = true; sample = true; ub = idx >> 2; uh = idx & 3; uu = 0; }
            else if (idx < att::N_DS + att::N_DP) { const int j = idx - att::N_DS; is_diff = true; sample = false; ub = (j & 31) >> 2; uh = j & 3; uu = 15 - (j >> 5); }
            else if (idx < att::N_DS + att::N_DP + att::N_SP) { const int j = idx - att::N_DS - att::N_DP; is_diff = false; sample = false; ub = (j & 63) >> 3; uh = j & 7; uu = 7 - (j >> 6); }
            else { const int j = idx - att::N_DS - att::N_DP - att::N_SP; is_diff = false; sample = true; ub = j >> 3; uh = j & 7; uu = 0; }
            if (is_diff) att::diff_unit(C, (LAS char*)lds, sample, ub, uh, uu);
            else att::sb_unit(C, (LAS char*)lds, sample, ub, uh, uu);
        }
    }
#endif
    grid.sync();
    {
        pg8::Gemm g{MIX, Wout_t, MT, DM, DM}; pg8::StaticOrder S; S.init(MT, DM, G, (int)blockIdx.x);
        pg8::EpiF32 E{Y, DM};
        pg8::gemm_phase<pg8::EpiF32, pg8::StaticOrder, true, true>(lds, g, S, E);
    }
    grid.sync();
    for (int row = gw; row < MT; row += NGW) {
        const float* xr = row < MP ? xp + (size_t)row * DM : xs + (size_t)(row - MP) * DM;
        p5_row(xr, Y + (size_t)row * DM, mod, p.in[11], p.in[19], p.out + (size_t)row * DM, XN + (size_t)row * DM, row_bi(row), lane);
    }
    grid.sync();
    {
        pg8::Gemm g{XN, Wup_t, MT, DFF, DM}; pg8::StaticOrder S; S.init(MT, DFF, G, (int)blockIdx.x);
        pg8::EpiRelu2 E{HB, DFF};
        pg8::gemm_phase<pg8::EpiRelu2, pg8::StaticOrder, true, true>(lds, g, S, E);
    }
    grid.sync();
    {
        pg8::Gemm g{HB, Wdn_t, MT, DM, DFF}; pg8::StaticOrder S; S.init(MT, DM, G, (int)blockIdx.x);
        pg8::EpiF32 E{Y, DM};
        pg8::gemm_phase<pg8::EpiF32, pg8::StaticOrder, true, true>(lds, g, S, E);
    }
    grid.sync();
    for (int row = gw; row < MT; row += NGW)
        p8_row(Y + (size_t)row * DM, mod, p.in[20], p.out + (size_t)row * DM, row_bi(row), lane);
}

extern "C" void kernel_launch(void* const* d_in, const int* in_sizes, int n_in, void* d_out, int out_size, void* d_ws, size_t ws_size, hipStream_t stream) {
    static int grid_blocks = 0;
    if (grid_blocks == 0) {
        if (n_in != 23 || ws_size < WS_END) { fprintf(stderr, "kernel_launch: unexpected n_in %d / ws_size %zu\n", n_in, ws_size); grid_blocks = -1; return; }
        int dev = 0, cus = 0, per_cu = 0;
        hipGetDevice(&dev);
        hipDeviceGetAttribute(&cus, hipDeviceAttributeMultiprocessorCount, dev);
        hipFuncSetAttribute((const void*)fwd_megakernel, hipFuncAttributeMaxDynamicSharedMemorySize, LDS_BYTES);
        hipOccupancyMaxActiveBlocksPerMultiprocessor(&per_cu, (const void*)fwd_megakernel, 512, LDS_BYTES);
        (void)hipGetLastError();
        if (per_cu < 1) per_cu = 1;
        grid_blocks = cus * 1;
    }
    if (grid_blocks < 0) return;
    Params p{};
    for (int i = 0; i < 23; ++i) p.in[i] = (const float*)d_in[i];
    p.out = (float*)d_out; p.ws = (unsigned char*)d_ws;
    void* args[] = {&p};
    hipError_t e = hipLaunchCooperativeKernel((const void*)fwd_megakernel, dim3(grid_blocks), dim3(512), args, LDS_BYTES, stream);
    if (e != hipSuccess) fprintf(stderr, "cooperative launch failed: %s (grid %d)\n", hipGetErrorString(e), grid_blocks);
}
```

```cpp
#include <hip/hip_runtime.h>
#include <hip/hip_cooperative_groups.h>
#include <cstdio>
#include <cstdint>
namespace cg = cooperative_groups;
namespace pg8 {
#define PG8_LAS __attribute__((address_space(3)))
typedef unsigned short bf16_t;
typedef short bf16x8 __attribute__((ext_vector_type(8)));
typedef float f32x4 __attribute__((ext_vector_type(4)));
typedef unsigned u32x4 __attribute__((ext_vector_type(4)));
constexpr int BM = 256, BK = 64, HALF = 128, HTB = HALF * BK * 2  , STAGE_BYTES = 8 * HTB, NXCD = 8, WGM = 8;

__host__ __device__ __forceinline__ int lds_byte(int r, int c) { const int st = (r >> 4) * 2 + (c >> 5), rr = r & 15, cc = c & 31, ob = rr * 64 + cc * 2; return st * 1024 + (ob ^ (((ob >> 9) & 1) << 5)); }
__host__ __device__ __forceinline__ void stage_rc(int b, int& R, int& C) { const int st = b / 1024, sb = b % 1024, swz = sb ^ (((sb >> 9) & 1) << 5); R = (st >> 1) * 16 + swz / 64; C = (st & 1) * 32 + (swz % 64) / 2; }
__host__ __device__ __forceinline__ int perm32(int rho) { const int n = rho >> 4, i = rho & 15; return 8 * (i >> 2) + 4 * n + (i & 3); }

struct Unit { int pm, pn; };
struct Gemm { const bf16_t* A; const bf16_t* Bt; int M, N, K; };

struct StaticOrder {
    int nM, nN, nwg, G, c;
    __host__ __device__ void init(int M, int N, int G_, int c_) { nM = M / BM; nN = N / BM; nwg = nM * nN; G = G_; c = c_; }
    __host__ __device__ bool next(int i, Unit& u) const {
        const long L = (long)i * G + c; if (L >= nwg) return false;
        int wgid = (int)L; { const int q = nwg / NXCD, r = nwg % NXCD, xcd = wgid % NXCD, off = wgid / NXCD; wgid = (xcd < r ? xcd * (q + 1) : r * (q + 1) + (xcd - r) * q) + off; }
        const int nig = WGM * nN, gid = wgid / nig, fm = gid * WGM, gsz = (nM - fm) < WGM ? (nM - fm) : WGM;
        u.pm = fm + ((wgid % nig) % gsz); u.pn = (wgid % nig) / gsz; return true;
    }
    __device__ __forceinline__ void a_ready(const Unit&) const {}
    __device__ __forceinline__ void done(const Unit&) const {}
};

__device__ __forceinline__ unsigned cvt_pk_bf16(float lo, float hi) { unsigned r; asm volatile("v_cvt_pk_bf16_f32 %0, %1, %2" : "=v"(r) : "v"(lo), "v"(hi)); return r; }
typedef float f32x2 __attribute__((ext_vector_type(2)));
__device__ __forceinline__ f32x2 gelu_pk(f32x2 v) {
    const f32x2 av = __builtin_elementwise_abs(v), d = av * 0.2316418882f + 1.0f;
    f32x2 t; t.x = __builtin_amdgcn_rcpf(d.x); t.y = __builtin_amdgcn_rcpf(d.y);
    f32x2 q = t * 0.5307027145f + (-0.7265760135f); q = q * t + 0.7107068705f; q = q * t + (-0.142248368f); q = q * t + 0.127414796f; q = q * t;
    const f32x2 s = (v * v) * (-0.72134752044f);
    f32x2 e; e.x = __builtin_amdgcn_exp2f(s.x); e.y = __builtin_amdgcn_exp2f(s.y);
    const f32x2 m = v * (q * e), r = v - m;
    f32x2 o; o.x = v.x < 0.f ? m.x : r.x; o.y = v.y < 0.f ? m.y : r.y; return o;
}

template <int ACT  > struct EpiBf16 {
    static constexpr bool PERM = true, AFTER_DRAIN = false; static_assert(ACT == 0 || ACT == 1, "EpiBf16: ACT is 0 (none) or 1 (gelu_pk)");
    bf16_t* O; int ldc; const float* bias; int split_cols; size_t split_stride; float scale0;
    __device__ __forceinline__ void operator()(const f32x4 (&acc)[2][2][4][2], const Unit& u, int wr, int wc, int fr, int fq) const {
        const int row0 = u.pm * BM + wr * 64 + fr; int colt = u.pn * BM; bf16_t* base = O;
        float sc = 1.f; if (split_cols) { const int t = colt / split_cols; base += (size_t)t * split_stride; colt -= t * split_cols; if (t == 0) sc = scale0; }
        const int col0 = colt + wc * 32 + 8 * fq, bcol0 = u.pn * BM + wc * 32 + 8 * fq;
        f32x4 bv[2][2];
#pragma unroll
        for (int bj = 0; bj < 2; ++bj)
#pragma unroll
            for (int n = 0; n < 2; ++n) bv[bj][n] = bias ? *(const f32x4*)(bias + bcol0 + bj * HALF + 4 * n) : (f32x4){0.f, 0.f, 0.f, 0.f};
#pragma unroll
        for (int ai = 0; ai < 2; ++ai)
#pragma unroll
            for (int m = 0; m < 4; ++m) { bf16_t* rowp = base + (size_t)(row0 + ai * HALF + m * 16) * ldc + col0;
#pragma unroll
                for (int bj = 0; bj < 2; ++bj) { f32x4 v0 = acc[ai][bj][m][0] + bv[bj][0], v1 = acc[ai][bj][m][1] + bv[bj][1];
                    if (ACT == 1) { f32x2 a = gelu_pk((f32x2){v0[0], v0[1]}), b = gelu_pk((f32x2){v0[2], v0[3]}), c = gelu_pk((f32x2){v1[0], v1[1]}), d = gelu_pk((f32x2){v1[2], v1[3]});
                        v0 = (f32x4){a.x, a.y, b.x, b.y}; v1 = (f32x4){c.x, c.y, d.x, d.y}; }
                    v0 = v0 * sc; v1 = v1 * sc; u32x4 w; w.x = cvt_pk_bf16(v0[0], v0[1]); w.y = cvt_pk_bf16(v0[2], v0[3]); w.z = cvt_pk_bf16(v1[0], v1[1]); w.w = cvt_pk_bf16(v1[2], v1[3]);
                    *(u32x4*)(rowp + bj * HALF) = w; } }
    }
};

template <class Epi, class Sched, bool ALIGN_EPI = false, bool SP2 = false>
__device__ __forceinline__ void gemm_phase(PG8_LAS unsigned char* lds, const Gemm g, const Sched& S, const Epi& E) {
    const int tid = threadIdx.x, wid = __builtin_amdgcn_readfirstlane(tid >> 6), lane = tid & 63, wr = wid >> 2, wc = wid & 3, fr = lane & 15, fq = lane >> 4;
    const int K = g.K, nt = K / BK;
    unsigned voffA[2], voffB[2];
#pragma unroll
    for (int i = 0; i < 2; ++i) { int R, C; stage_rc(tid * 16 + i * 8192, R, C); const int Rb = Epi::PERM ? ((R & ~31) + perm32(R & 31)) : R;
        voffA[i] = (unsigned)(R * K + C) * 2u; voffB[i] = (unsigned)(Rb * K + C) * 2u; }
    const size_t kstep = (size_t)(BK * 2);
    const size_t hstep = (size_t)HALF * K * 2;
    const size_t tstep = 2 * hstep;
    const unsigned ldsw = (unsigned)wid * 1024u;
    const int aoff = lds_byte(wr * 64 + fr, fq * 8), boff = lds_byte(wc * 32 + fr, fq * 8);
#define PG8_SA(b, h) (((b) * 2 + (h)) * HTB)
#define PG8_SB(b, h) ((4 + (b) * 2 + (h)) * HTB)
#define PG8_STAGE(bufoff, gbase, voff) do { _Pragma("unroll") for (int _i = 0; _i < 2; ++_i) \
        __builtin_amdgcn_global_load_lds((const unsigned*)((const char*)(gbase) + (voff)[_i]), (PG8_LAS unsigned*)(lds + (bufoff) + ldsw + _i * 8192), 16, 0, 0); } while (0)
#define PG8_LDA(dst, b, h) do { _Pragma("unroll") for (int m = 0; m < 4; ++m) _Pragma("unroll") for (int k = 0; k < 2; ++k) dst[m][k] = *(const PG8_LAS bf16x8*)(lds + PG8_SA(b, h) + aoff + m * 2048 + k * 1024); } while (0)
#define PG8_LDB(dst, b, h) do { _Pragma("unroll") for (int n = 0; n < 2; ++n) _Pragma("unroll") for (int k = 0; k < 2; ++k) dst[n][k] = *(const PG8_LAS bf16x8*)(lds + PG8_SB(b, h) + boff + n * 2048 + k * 1024); } while (0)
#define PG8_MMA(ai, bj, At, Bt) do { __builtin_amdgcn_s_setprio(1); _Pragma("unroll") for (int m = 0; m < 4; ++m) _Pragma("unroll") for (int n = 0; n < 2; ++n) _Pragma("unroll") for (int k = 0; k < 2; ++k) \
        acc[ai][bj][m][n] = __builtin_amdgcn_mfma_f32_16x16x32_bf16(Bt[n][k], At[m][k], acc[ai][bj][m][n], 0, 0, 0); __builtin_amdgcn_s_setprio(0); } while (0)
#define PG8_WAIT_V(n) asm volatile("s_waitcnt vmcnt(" #n ")" ::: "memory")
#define PG8_WAIT_L(n) asm volatile("s_waitcnt lgkmcnt(" #n ")" ::: "memory")
#define PG8_BAR __builtin_amdgcn_s_barrier()
#define PG8_SCHED __builtin_amdgcn_sched_barrier(0)
    Unit cur, nxt; int ui = 0;
    if (!S.next(0, cur)) return;
    f32x4 acc[2][2][4][2];
#pragma unroll
    for (int a = 0; a < 2; ++a)
#pragma unroll
        for (int b = 0; b < 2; ++b)
#pragma unroll
            for (int m = 0; m < 4; ++m)
#pragma unroll
                for (int n = 0; n < 2; ++n) acc[a][b][m][n] = (f32x4){0.f, 0.f, 0.f, 0.f};
    bf16x8 At[4][2], B0[2][2], B1[2][2];
    const char* cA = (const char*)g.A + (size_t)cur.pm * tstep; const char* cB = (const char*)g.Bt + (size_t)cur.pn * tstep;
    S.a_ready(cur);
    if constexpr (SP2) {
        PG8_STAGE(PG8_SB(0, 0), cB, voffB); PG8_STAGE(PG8_SB(0, 1), cB + hstep, voffB); PG8_STAGE(PG8_SA(0, 0), cA, voffA); PG8_STAGE(PG8_SA(0, 1), cA + hstep, voffA);
        if (wr == 1) PG8_BAR;
        PG8_WAIT_V(2); PG8_BAR;
        PG8_STAGE(PG8_SB(1, 0), cB + kstep, voffB); PG8_STAGE(PG8_SA(1, 0), cA + kstep, voffA); PG8_STAGE(PG8_SB(1, 1), cB + hstep + kstep, voffB);
        PG8_WAIT_V(6); PG8_BAR;
    } else {
        PG8_STAGE(PG8_SB(0, 0), cB, voffB); PG8_STAGE(PG8_SA(0, 0), cA, voffA); PG8_STAGE(PG8_SB(0, 1), cB + hstep, voffB); PG8_STAGE(PG8_SA(0, 1), cA + hstep, voffA);
        if (wr == 1) PG8_BAR;
        PG8_WAIT_V(4); PG8_BAR;
        PG8_STAGE(PG8_SB(1, 0), cB + kstep, voffB); PG8_STAGE(PG8_SA(1, 0), cA + kstep, voffA); PG8_STAGE(PG8_SB(1, 1), cB + hstep + kstep, voffB);
        PG8_WAIT_V(6); PG8_BAR;
    }
    for (;;) {
        const bool has_next = S.next(ui + 1, nxt);
        const char* nA = has_next ? (const char*)g.A + (size_t)nxt.pm * tstep : cA; const char* nB = has_next ? (const char*)g.Bt + (size_t)nxt.pn * tstep : cB;
        for (int t = 0; t < nt; t += 2) {
            const bool last = (t == nt - 2);
            const char* a1 = cA + (size_t)(t + 1) * kstep;
            const char* a2 = last ? nA : cA + (size_t)(t + 2) * kstep; const char* b2 = last ? nB : cB + (size_t)(t + 2) * kstep;
            const char* a3 = a2 + kstep; const char* b3 = b2 + kstep;
            if (last && has_next) S.a_ready(nxt);
            if constexpr (SP2) {
            PG8_LDB(B0, 0, 0); PG8_LDB(B1, 0, 1); PG8_SCHED; PG8_LDA(At, 0, 0); PG8_STAGE(PG8_SA(1, 1), a1 + hstep, voffA);
            PG8_WAIT_V(8); PG8_WAIT_L(0); PG8_BAR; PG8_MMA(0, 0, At, B0); PG8_MMA(0, 1, At, B1); PG8_BAR; PG8_SCHED;
            PG8_LDA(At, 0, 1); PG8_STAGE(PG8_SB(0, 0), b2, voffB); PG8_STAGE(PG8_SB(0, 1), b2 + hstep, voffB); PG8_STAGE(PG8_SA(0, 0), a2, voffA);
            PG8_WAIT_V(8); PG8_WAIT_L(0); PG8_BAR; PG8_MMA(1, 0, At, B0); PG8_MMA(1, 1, At, B1); PG8_BAR; PG8_SCHED;
            PG8_LDB(B0, 1, 0); PG8_LDB(B1, 1, 1); PG8_SCHED; PG8_LDA(At, 1, 0); PG8_STAGE(PG8_SA(0, 1), a2 + hstep, voffA);
            PG8_WAIT_V(8); PG8_WAIT_L(0); PG8_BAR; PG8_MMA(0, 0, At, B0); PG8_MMA(0, 1, At, B1); PG8_BAR; PG8_SCHED;
            PG8_LDA(At, 1, 1); PG8_STAGE(PG8_SB(1, 0), b3, voffB); PG8_STAGE(PG8_SB(1, 1), b3 + hstep, voffB); PG8_STAGE(PG8_SA(1, 0), a3, voffA);
            PG8_WAIT_V(8); PG8_WAIT_L(0); PG8_BAR; PG8_MMA(1, 0, At, B0); PG8_MMA(1, 1, At, B1); PG8_BAR; PG8_SCHED;
            } else {
            PG8_LDB(B0, 0, 0); PG8_SCHED; PG8_LDA(At, 0, 0); PG8_STAGE(PG8_SA(1, 1), a1 + hstep, voffA);
            PG8_WAIT_L(8); PG8_BAR; PG8_WAIT_L(0); PG8_MMA(0, 0, At, B0); PG8_BAR; PG8_SCHED;
            PG8_LDB(B1, 0, 1); PG8_STAGE(PG8_SB(0, 0), b2, voffB);
            PG8_BAR; PG8_WAIT_L(0); PG8_MMA(0, 1, At, B1); PG8_BAR;
            PG8_LDA(At, 0, 1); PG8_STAGE(PG8_SA(0, 0), a2, voffA);
            PG8_BAR; PG8_WAIT_L(0); PG8_MMA(1, 0, At, B0); PG8_BAR; PG8_SCHED;
            PG8_STAGE(PG8_SB(0, 1), b2 + hstep, voffB);
            PG8_WAIT_V(6); PG8_BAR; PG8_MMA(1, 1, At, B1); PG8_BAR;
            PG8_LDB(B0, 1, 0); PG8_SCHED; PG8_LDA(At, 1, 0); PG8_STAGE(PG8_SA(0, 1), a2 + hstep, voffA);
            PG8_WAIT_L(8); PG8_BAR; PG8_WAIT_L(0); PG8_MMA(0, 0, At, B0); PG8_BAR; PG8_SCHED;
            PG8_LDB(B1, 1, 1); PG8_STAGE(PG8_SB(1, 0), b3, voffB);
            PG8_BAR; PG8_WAIT_L(0); PG8_MMA(0, 1, At, B1); PG8_BAR;
            PG8_LDA(At, 1, 1); PG8_STAGE(PG8_SA(1, 0), a3, voffA);
            PG8_BAR; PG8_WAIT_L(0); PG8_MMA(1, 0, At, B0); PG8_BAR; PG8_SCHED;
            PG8_STAGE(PG8_SB(1, 1), b3 + hstep, voffB);
            PG8_WAIT_V(6); PG8_BAR; PG8_MMA(1, 1, At, B1); PG8_BAR;
            }
        }
        if constexpr (ALIGN_EPI) { if (wr == 0) PG8_BAR; }
        if constexpr (!Epi::AFTER_DRAIN) { E(acc, cur, wr, wc, fr, fq); S.done(cur); }
        if (!has_next) break;
#pragma unroll
        for (int a = 0; a < 2; ++a)
#pragma unroll
            for (int b = 0; b < 2; ++b)
#pragma unroll
                for (int m = 0; m < 4; ++m)
#pragma unroll
                    for (int n = 0; n < 2; ++n) acc[a][b][m][n] = (f32x4){0.f, 0.f, 0.f, 0.f};
        cur = nxt; cA = nA; cB = nB; ++ui;
        if constexpr (ALIGN_EPI) { if (wr == 1) PG8_BAR; }
    }
    PG8_WAIT_V(0);
    if constexpr (!ALIGN_EPI) { if (wr == 0) PG8_BAR; }
    PG8_BAR;
    if constexpr (Epi::AFTER_DRAIN) { E.fused(acc, cur, wr, wc, fr, fq, lds, wid, lane); S.done(cur); }
#undef PG8_SA
#undef PG8_SB
#undef PG8_STAGE
#undef PG8_LDA
#undef PG8_LDB
#undef PG8_MMA
#undef PG8_WAIT_V
#undef PG8_WAIT_L
#undef PG8_BAR
#undef PG8_SCHED
}
}

#ifndef REP_ATT
#define REP_ATT 1
#endif
#ifndef REP_GEMM
#define REP_GEMM 1
#endif
#ifndef REP_ROW
#define REP_ROW 1
#endif
#ifndef REP_SYNC
#define REP_SYNC 0
#endif
#ifndef REP_P0
#define REP_P0 1
#endif
constexpr int DM = 1024, NB = 8, SEQ = 2048, DB = 16, DSEQ = 64, PAST = 2048;
constexpr int MP = NB * SEQ, MS = DB * DSEQ, MT = MP + MS;
constexpr int NIN = 3072, DFF = 4096, NMOD = 6 * DM;
constexpr float EPS = 1e-6f;
constexpr float LOG2E = 1.4426950408889634f;
constexpr size_t O_KVP = (size_t)MT * DM;
constexpr size_t KVP_SZ = (size_t)MP * 512;
constexpr size_t O_KVS = O_KVP + 4 * KVP_SZ;
constexpr size_t KVS_SZ = (size_t)MS * 512;
constexpr size_t MiB = 1u << 20;
constexpr size_t WS_CTL = 0, WS_MOD = 1 * MiB, WS_WIN = 2 * MiB, WS_WOUT = 8 * MiB, WS_WUP = 10 * MiB, WS_WDN = 18 * MiB;
constexpr size_t WS_XN = 26 * MiB, WS_U = 60 * MiB, WS_MIX = 162 * MiB, WS_HB = 60 * MiB, WS_Y = 196 * MiB, WS_END = 264 * MiB;
static_assert(WS_XN + (size_t)MT * DM * 2 <= WS_U && WS_U + (size_t)MT * NIN * 2 <= WS_MIX && WS_MIX + (size_t)MT * DM * 2 <= WS_Y && WS_HB + (size_t)MT * DFF * 2 <= WS_Y && WS_Y + (size_t)MT * DM * 4 <= WS_END, "ws map");
constexpr int LDS_BYTES = 131072 + 1024;
constexpr int LDS_MISC = 131072;
constexpr int CW_BAR = 4096;
constexpr size_t CTL_ZERO_BYTES = 65536;

#define LAS __attribute__((address_space(3)))
#define DI __device__ __forceinline__
typedef unsigned short bf16_t;
typedef short bf16x8 __attribute__((ext_vector_type(8)));
typedef short s16x4 __attribute__((ext_vector_type(4)));
typedef float f32x4 __attribute__((ext_vector_type(4)));
typedef float f32x16 __attribute__((ext_vector_type(16)));
typedef unsigned u32x4 __attribute__((ext_vector_type(4)));
typedef unsigned u32x2 __attribute__((ext_vector_type(2)));
typedef float f32x2_t __attribute__((ext_vector_type(2)));
typedef __bf16 bf16x2_t __attribute__((ext_vector_type(2)));
DI unsigned cvtpk(float lo, float hi) { f32x2_t v = {lo, hi}; bf16x2_t b = __builtin_convertvector(v, bf16x2_t); return __builtin_bit_cast(unsigned, b); }
#define LDS_WAIT() asm volatile("s_waitcnt lgkmcnt(0)" ::: "memory")

namespace pg8 {
struct EpiQKV {
    static constexpr bool PERM = true, AFTER_DRAIN = false;
    bf16_t* U; float* out;
    __device__ __forceinline__ void operator()(const f32x4 (&acc)[2][2][4][2], const Unit& u, int wr, int wc, int fr, int fq) const {
        const int sec = u.pn >> 1;
        const bool kv = (sec == 1) || (sec == 2) || (sec == 4) || (sec == 5);
        const int kvi = (sec == 1) ? 0 : (sec == 2) ? 1 : (sec == 4) ? 2 : 3;
        const bool prompt = u.pm < (MP / BM);
        float* fbase = prompt ? out + O_KVP + (size_t)kvi * KVP_SZ : out + O_KVS + (size_t)kvi * KVS_SZ - (size_t)MP * 512;
        const int row0 = u.pm * BM + wr * 64 + fr, col0 = u.pn * BM + wc * 32 + 8 * fq, colsec = col0 - sec * 512;
#pragma unroll
        for (int ai = 0; ai < 2; ++ai)
#pragma unroll
            for (int m = 0; m < 4; ++m) { const int row = row0 + ai * HALF + m * 16;
#pragma unroll
                for (int bj = 0; bj < 2; ++bj) { const f32x4 v0 = acc[ai][bj][m][0], v1 = acc[ai][bj][m][1];
                    u32x4 w; w.x = cvt_pk_bf16(v0[0], v0[1]); w.y = cvt_pk_bf16(v0[2], v0[3]); w.z = cvt_pk_bf16(v1[0], v1[1]); w.w = cvt_pk_bf16(v1[2], v1[3]);
                    *(u32x4*)(U + (size_t)row * NIN + col0 + bj * HALF) = w;
                    if (kv) { float* d = fbase + (size_t)row * 512 + colsec + bj * HALF; *(f32x4*)d = v0; *(f32x4*)(d + 4) = v1; } } }
    }
};
struct EpiF32 {
    static constexpr bool PERM = true, AFTER_DRAIN = false;
    float* Y; int ldc;
    __device__ __forceinline__ void operator()(const f32x4 (&acc)[2][2][4][2], const Unit& u, int wr, int wc, int fr, int fq) const {
        const int row0 = u.pm * BM + wr * 64 + fr, col0 = u.pn * BM + wc * 32 + 8 * fq;
#pragma unroll
        for (int ai = 0; ai < 2; ++ai)
#pragma unroll
            for (int m = 0; m < 4; ++m) { float* rowp = Y + (size_t)(row0 + ai * HALF + m * 16) * ldc + col0;
#pragma unroll
                for (int bj = 0; bj < 2; ++bj) { *(f32x4*)(rowp + bj * HALF) = acc[ai][bj][m][0]; *(f32x4*)(rowp + bj * HALF + 4) = acc[ai][bj][m][1]; } }
    }
};
struct EpiRelu2 {
    static constexpr bool PERM = true, AFTER_DRAIN = false;
    bf16_t* O; int ldc;
    __device__ __forceinline__ void operator()(const f32x4 (&acc)[2][2][4][2], const Unit& u, int wr, int wc, int fr, int fq) const {
        const int row0 = u.pm * BM + wr * 64 + fr, col0 = u.pn * BM + wc * 32 + 8 * fq;
#pragma unroll
        for (int ai = 0; ai < 2; ++ai)
#pragma unroll
            for (int m = 0; m < 4; ++m) { bf16_t* rowp = O + (size_t)(row0 + ai * HALF + m * 16) * ldc + col0;
#pragma unroll
                for (int bj = 0; bj < 2; ++bj) { f32x4 v0 = acc[ai][bj][m][0], v1 = acc[ai][bj][m][1];
                    v0 = __builtin_elementwise_max(v0, (f32x4){0.f, 0.f, 0.f, 0.f}); v1 = __builtin_elementwise_max(v1, (f32x4){0.f, 0.f, 0.f, 0.f}); v0 = v0 * v0; v1 = v1 * v1;
                    u32x4 w; w.x = cvt_pk_bf16(v0[0], v0[1]); w.y = cvt_pk_bf16(v0[2], v0[3]); w.z = cvt_pk_bf16(v1[0], v1[1]); w.w = cvt_pk_bf16(v1[2], v1[3]);
                    *(u32x4*)(rowp + bj * HALF) = w; } }
    }
};
}

DI float wave_sum(float v) {
#pragma unroll
    for (int o = 1; o < 64; o <<= 1) v += __shfl_xor(v, o);
    return v;
}
DI unsigned f2bf(float f) { unsigned u = __builtin_bit_cast(unsigned, f); return (u + 0x7fffu + ((u >> 16) & 1u)) >> 16; }
DI unsigned pk2(float lo, float hi) { return f2bf(lo) | (f2bf(hi) << 16); }
DI float xswap_add(float v) { auto rr = __builtin_amdgcn_permlane32_swap(__float_as_uint(v), __float_as_uint(v), false, false); return __uint_as_float(rr[0]) + __uint_as_float(rr[1]); }
DI float xswap_max(float v) { auto rr = __builtin_amdgcn_permlane32_swap(__float_as_uint(v), __float_as_uint(v), false, false); return fmaxf(__uint_as_float(rr[0]), __uint_as_float(rr[1])); }

DI void p0_transpose_item(const float* W, int K, int N, bf16_t* WT, LAS float* scr, int item, int lane) {
    const int nblk = N / 32, kb = item / nblk, nb = item % nblk, k0 = 64 * kb, n0 = 32 * nb;
#pragma unroll 8
    for (int i = 0; i < 32; ++i) { const int kk = 2 * i + (lane >> 5); scr[kk * 33 + (lane & 31)] = W[(size_t)(k0 + kk) * N + n0 + (lane & 31)]; }
    LDS_WAIT();
    const int c = lane & 7;
#pragma unroll
    for (int j = 0; j < 4; ++j) { const int n = (lane >> 3) + 8 * j; const LAS float* s = scr + (8 * c) * 33 + n;
        u32x4 o; o.x = pk2(s[0 * 33], s[1 * 33]); o.y = pk2(s[2 * 33], s[3 * 33]); o.z = pk2(s[4 * 33], s[5 * 33]); o.w = pk2(s[6 * 33], s[7 * 33]);
        *(u32x4*)(WT + (size_t)(n0 + n) * K + k0 + 8 * c) = o; }
    LDS_WAIT();
}
DI void p0_modulate_block(const float* cp, const float* cs, const float* w_ada, const float* b_ada, float* mod, LAS unsigned char* lds, int item, int tid, int lane, int wave) {
    LAS float* scr = (LAS float*)(lds + wave * 16384);
    LAS float* red = (LAS float*)(lds + wave * 16384 + 12288);
    for (int e = lane; e < 24 * 128; e += 64) { const int bi = e >> 7, j = e & 127;
        const float v = (bi < 8) ? cp[bi * DM + 128 * wave + j] : cs[(bi - 8) * DM + 128 * wave + j];
        scr[e] = v / (1.f + __expf(-v)); }
    LDS_WAIT();
    const int kh = lane >> 5;
    const float* wp = w_ada + (size_t)(128 * wave + 64 * kh) * NMOD + item * 32 + (lane & 31);
    float acc[24];
#pragma unroll
    for (int bi = 0; bi < 24; ++bi) acc[bi] = 0.f;
#pragma unroll 4
    for (int j4 = 0; j4 < 16; ++j4) {
        float wv[4];
#pragma unroll
        for (int q = 0; q < 4; ++q) wv[q] = wp[(size_t)(4 * j4 + q) * NMOD];
#pragma unroll
        for (int bi = 0; bi < 24; ++bi) { const f32x4 sv = *(const LAS f32x4*)(scr + bi * 128 + 64 * kh + 4 * j4); acc[bi] += (sv.x * wv[0] + sv.y * wv[1]) + (sv.z * wv[2] + sv.w * wv[3]); }
    }
#pragma unroll
    for (int bi = 0; bi < 24; ++bi) acc[bi] += __shfl_xor(acc[bi], 32);
    if (lane < 32) {
#pragma unroll
        for (int bi = 0; bi < 24; ++bi) red[bi * 32 + lane] = acc[bi]; }
    __syncthreads();
    for (int e = tid; e < 24 * 32; e += 512) { float sum = 0.f;
#pragma unroll
        for (int w8 = 0; w8 < 8; ++w8) sum += ((const LAS float*)(lds + w8 * 16384 + 12288))[e];
        const int c = item * 32 + (e & 31); mod[(e >> 5) * NMOD + c] = sum + b_ada[c]; }
    __syncthreads();
}

DI int row_bi(int row) { return row < MP ? (row >> 11) : 8 + ((row - MP) >> 6); }
DI void p1_row(const float* xrow, const float* mod, const float* g, bf16_t* orow, int bi, int lane) {
    const f32x4* xr = (const f32x4*)xrow + lane; f32x4 v[4]; float s = 0.f;
#pragma unroll
    for (int j = 0; j < 4; ++j) { v[j] = xr[64 * j]; s += (v[j].x * v[j].x + v[j].y * v[j].y) + (v[j].z * v[j].z + v[j].w * v[j].w); }
    const float r = rsqrtf(wave_sum(s) * (1.f / DM) + EPS);
    const f32x4* gg = (const f32x4*)g + lane; const f32x4* sh = (const f32x4*)(mod + (size_t)bi * NMOD) + lane; const f32x4* sc = (const f32x4*)(mod + (size_t)bi * NMOD + DM) + lane;
    u32x2* o8 = (u32x2*)orow + lane;
#pragma unroll
    for (int j = 0; j < 4; ++j) { const f32x4 h = v[j] * r * gg[64 * j] * (sc[64 * j] + 1.f) + sh[64 * j]; u32x2 w; w.x = cvtpk(h.x, h.y); w.y = cvtpk(h.z, h.w); o8[64 * j] = w; }
}
DI void p5_row(const float* xrow, const float* yrow, const float* mod, const float* gpost, const float* gpre2, float* outrow, bf16_t* xnrow, int bi, int lane) {
    const f32x4* xr = (const f32x4*)xrow + lane; const f32x4* yr = (const f32x4*)yrow + lane; f32x4 y[4], x1[4]; float s = 0.f;
#pragma unroll
    for (int j = 0; j < 4; ++j) { y[j] = yr[64 * j]; s += (y[j].x * y[j].x + y[j].y * y[j].y) + (y[j].z * y[j].z + y[j].w * y[j].w); }
    const float r1 = rsqrtf(wave_sum(s) * (1.f / DM) + EPS);
    const float* mb = mod + (size_t)bi * NMOD;
    const f32x4* gp = (const f32x4*)gpost + lane; const f32x4* ga = (const f32x4*)(mb + 2 * DM) + lane;
    float s2 = 0.f; f32x4* orow = (f32x4*)outrow + lane;
#pragma unroll
    for (int j = 0; j < 4; ++j) { x1[j] = xr[64 * j] + ga[64 * j] * (y[j] * r1 * gp[64 * j]); orow[64 * j] = x1[j];
        s2 += (x1[j].x * x1[j].x + x1[j].y * x1[j].y) + (x1[j].z * x1[j].z + x1[j].w * x1[j].w); }
    const float r2 = rsqrtf(wave_sum(s2) * (1.f / DM) + EPS);
    const f32x4* g2 = (const f32x4*)gpre2 + lane; const f32x4* sh = (const f32x4*)(mb + 3 * DM) + lane; const f32x4* sc = (const f32x4*)(mb + 4 * DM) + lane;
    u32x2* o8 = (u32x2*)xnrow + lane;
#pragma unroll
    for (int j = 0; j < 4; ++j) { const f32x4 h = x1[j] * r2 * g2[64 * j] * (sc[64 * j] + 1.f) + sh[64 * j]; u32x2 w; w.x = cvtpk(h.x, h.y); w.y = cvtpk(h.z, h.w); o8[64 * j] = w; }
}
DI void p8_row(const float* yrow, const float* mod, const float* gpost, float* outrow, int bi, int lane) {
    const f32x4* yr = (const f32x4*)yrow + lane; f32x4 y[4]; float s = 0.f;
#pragma unroll
    for (int j = 0; j < 4; ++j) { y[j] = yr[64 * j]; s += (y[j].x * y[j].x + y[j].y * y[j].y) + (y[j].z * y[j].z + y[j].w * y[j].w); }
    const float r1 = rsqrtf(wave_sum(s) * (1.f / DM) + EPS);
    const f32x4* gp = (const f32x4*)gpost + lane; const f32x4* ga = (const f32x4*)(mod + (size_t)bi * NMOD + 5 * DM) + lane; f32x4* orow = (f32x4*)outrow + lane;
#pragma unroll
    for (int j = 0; j < 4; ++j) orow[64 * j] = orow[64 * j] + ga[64 * j] * (y[j] * r1 * gp[64 * j]);
}

namespace att {
#define MFMA32(a, b, c) __builtin_amdgcn_mfma_f32_32x32x16_bf16((a), (b), (c), 0, 0, 0)
typedef short v4i16_t __attribute__((ext_vector_type(4)));
DI unsigned off_b(unsigned row, unsigned ch) { return 256u * row + 16u * (ch ^ (((row & 3u) << 2) | ((row >> 2) & 3u))); }
DI s16x4 trr(const LAS char* p) { return __builtin_bit_cast(s16x4, __builtin_amdgcn_ds_read_tr16_b64_v4i16((LAS v4i16_t*)p)); }
DI bf16x8 cat8(s16x4 lo, s16x4 hi) { return (bf16x8){lo[0], lo[1], lo[2], lo[3], hi[0], hi[1], hi[2], hi[3]}; }
template <int S> DI bf16x8 pack8(const f32x16& x) { u32x4 p; p[0] = cvtpk(x[8 * S], x[8 * S + 1]); p[1] = cvtpk(x[8 * S + 2], x[8 * S + 3]); p[2] = cvtpk(x[8 * S + 4], x[8 * S + 5]); p[3] = cvtpk(x[8 * S + 6], x[8 * S + 7]); return __builtin_bit_cast(bf16x8, p); }
DI u32x4 cvt8(u32x4 a, u32x4 b) {
    u32x4 o; o.x = cvtpk(__uint_as_float(a.x), __uint_as_float(a.y)); o.y = cvtpk(__uint_as_float(a.z), __uint_as_float(a.w));
    o.z = cvtpk(__uint_as_float(b.x), __uint_as_float(b.y)); o.w = cvtpk(__uint_as_float(b.z), __uint_as_float(b.w)); return o; }

struct Ctx {
    const bf16_t* U; bf16_t* MIX;
    const float *cdk, *cdv, *csk, *csv;
    const float* subg; float lam;
};

DI void diff_unit(const Ctx& C, LAS char* lds, bool sample, int b, int hh, int u) {
    int tid_ = threadIdx.x; asm volatile("" : "+v"(tid_));
    const int tid = tid_, lane = tid & 63, r = lane & 31, h = lane >> 5, w = __builtin_amdgcn_readfirstlane(tid >> 6);
    const int qblk = w >> 1, map = w & 1;
    const bool active = sample ? (w < 4) : true;
    const int ncache = sample ? 32 : 0;
    const int tokbase = sample ? MP + b * DSEQ : b * SEQ;
    const int cbase = b * PAST;
    const int Tmax = sample ? 32 : 2 * u + 1;
    const int qrel = sample ? 32 * qblk : 128 * u + 32 * qblk;
    const int Tw = sample ? 32 : (qrel >> 6);
    const int qpos = (sample ? PAST : 0) + qrel + r;
    const int qrow = tokbase + (active ? qrel : 0) + r;
    bf16x8 qf[4];
#pragma unroll
    for (int ds = 0; ds < 4; ++ds) qf[ds] = *(const bf16x8*)(C.U + (size_t)qrow * NIN + hh * 128 + map * 64 + 16 * ds + 8 * h);
    unsigned kaddr[4];
    { const unsigned x = ((r & 3u) << 2) | ((r >> 2) & 3u);
#pragma unroll
      for (int ds = 0; ds < 4; ++ds) kaddr[ds] = 256u * r + 16u * ((unsigned)(2 * (4 * map + ds) + h) ^ x); }
    unsigned vaddr[2][4];
    { const unsigned blk = (lane >> 4) & 1, q = (lane & 15) >> 2, p = lane & 3;
#pragma unroll
      for (int t = 0; t < 2; ++t)
#pragma unroll
          for (int c = 0; c < 4; ++c) vaddr[t][c] = off_b(8 * t + 4 * h + q, 4 * c + 2 * blk + (p >> 1)) + 8 * (p & 1); }
    const int srow = tid >> 4, sch = tid & 15;
    const unsigned sdst0 = off_b(srow, sch), sdst1 = off_b(srow + 32, sch);
    u32x4 st[4];
    auto issue = [&](int t, int isv) {
        if (t < ncache) {
            const float* src = isv ? C.cdv : C.cdk;
            const size_t o0 = (size_t)(cbase + 64 * t + srow) * 512 + hh * 128 + sch * 8, o1 = o0 + (size_t)32 * 512;
            st[0] = *(const u32x4*)(src + o0); st[1] = *(const u32x4*)(src + o0 + 4); st[2] = *(const u32x4*)(src + o1); st[3] = *(const u32x4*)(src + o1 + 4);
        } else {
            const bf16_t* g0 = C.U + (size_t)(tokbase + 64 * (t - ncache) + srow) * NIN + hh * 128 + sch * 8 + (isv ? 1024 : 512);
            st[0] = *(const u32x4*)g0; st[1] = *(const u32x4*)(g0 + (size_t)32 * NIN);
        }
    };
    auto commit = [&](int t, int buf, int isv) {
        LAS char* img = lds + buf * 32768 + (isv ? 16384 : 0);
        if (t < ncache) { *(LAS u32x4*)(img + sdst0) = cvt8(st[0], st[1]); *(LAS u32x4*)(img + sdst1) = cvt8(st[2], st[3]); }
        else { *(LAS u32x4*)(img + sdst0) = st[0]; *(LAS u32x4*)(img + sdst1) = st[1]; }
    };
    const float slope = __builtin_amdgcn_exp2f(-2.f * (float)(hh + 1));
    const float c1 = 0.125f * LOG2E, sl2 = slope * LOG2E;
    f32x16 o[4];
#pragma unroll
    for (int dt = 0; dt < 4; ++dt)
#pragma unroll
        for (int i = 0; i < 16; ++i) o[dt][i] = 0.f;
    float mrun = -1e30f, lrun = 0.f;

    issue(Tmax, 0); commit(Tmax, 0, 0); issue(Tmax, 1); commit(Tmax, 0, 1); __syncthreads();
    int cur = 0;
    for (int t = Tmax; t >= 0; --t) {
        const bool comp = active && t <= Tw;
        const LAS char* kimg = lds + cur * 32768; const LAS char* vimg = kimg + 16384;
        bf16x8 P[4];
        if (t > 0) issue(t - 1, 0);
        if (comp) {
            f32x16 s0, s1;
#pragma unroll
            for (int i = 0; i < 16; ++i) { s0[i] = 0.f; s1[i] = 0.f; }
#pragma unroll
            for (int ds = 0; ds < 4; ++ds) {
                const bf16x8 k0 = *(const LAS bf16x8*)(kimg + kaddr[ds]); const bf16x8 k1 = *(const LAS bf16x8*)(kimg + kaddr[ds] + 8192);
                s0 = MFMA32(k0, qf[ds], s0); s1 = MFMA32(k1, qf[ds], s1); }
            const float d0 = (float)(qpos - 64 * t - 4 * h);
            float mx = -1e30f;
#pragma unroll
            for (int i = 0; i < 16; ++i) { const float ci = (float)((i & 3) + 8 * (i >> 2));
                s0[i] = s0[i] * c1 - sl2 * fabsf(d0 - ci); s1[i] = s1[i] * c1 - sl2 * fabsf(d0 - 32.f - ci);
                mx = fmaxf(mx, fmaxf(s0[i], s1[i])); }
            mx = xswap_max(mx);
            const float mnew = fmaxf(mrun, mx);
            if (__any(mnew > mrun)) { const float alpha = __builtin_amdgcn_exp2f(mrun - mnew); lrun *= alpha; mrun = mnew;
#pragma unroll
                for (int dt = 0; dt < 4; ++dt)
#pragma unroll
                    for (int i = 0; i < 16; ++i) o[dt][i] *= alpha; }
            float ps = 0.f;
#pragma unroll
            for (int i = 0; i < 16; ++i) { s0[i] = __builtin_amdgcn_exp2f(s0[i] - mrun); s1[i] = __builtin_amdgcn_exp2f(s1[i] - mrun); ps += s0[i] + s1[i]; }
            lrun += ps;
            P[0] = pack8<0>(s0); P[1] = pack8<1>(s0); P[2] = pack8<0>(s1); P[3] = pack8<1>(s1);
        }
        if (t > 0) { commit(t - 1, cur ^ 1, 0); issue(t - 1, 1); }
        if (comp) {
#pragma unroll
            for (int dt = 0; dt < 4; ++dt)
#pragma unroll
                for (int ks = 0; ks < 4; ++ks) { const s16x4 lo = trr(vimg + vaddr[0][dt] + 4096 * ks), hi = trr(vimg + vaddr[1][dt] + 4096 * ks);
                    o[dt] = MFMA32(cat8(lo, hi), P[ks], o[dt]); }
        }
        if (t > 0) commit(t - 1, cur ^ 1, 1);
        __syncthreads();
        cur ^= 1;
    }
    const float inv = 1.f / xswap_add(lrun);
    LAS float* X = (LAS float*)(lds + (w >> 1) * 16384);
    if (active && map == 1) { const float f = C.lam * inv;
#pragma unroll
        for (int dt = 0; dt < 4; ++dt)
#pragma unroll
            for (int i = 0; i < 16; ++i) X[(dt * 16 + i) * 64 + lane] = o[dt][i] * f; }
    __syncthreads();
    if (active && map == 0) { float ss = 0.f;
#pragma unroll
        for (int dt = 0; dt < 4; ++dt)
#pragma unroll
            for (int i = 0; i < 16; ++i) { const float v = o[dt][i] * inv - X[(dt * 16 + i) * 64 + lane]; o[dt][i] = v; ss += v * v; }
        ss = xswap_add(ss);
        const float rn = rsqrtf(ss * (1.f / 128.f) + EPS) * 0.8f;
        bf16_t* orow = C.MIX + (size_t)qrow * DM + hh * 128;
#pragma unroll
        for (int dt = 0; dt < 4; ++dt)
#pragma unroll
            for (int g = 0; g < 4; ++g) { const int d = 32 * dt + 8 * g + 4 * h; const f32x4 gg = *(const f32x4*)(C.subg + d);
                u32x2 wv; wv.x = cvtpk(o[dt][4 * g] * rn * gg.x, o[dt][4 * g + 1] * rn * gg.y); wv.y = cvtpk(o[dt][4 * g + 2] * rn * gg.z, o[dt][4 * g + 3] * rn * gg.w);
                *(u32x2*)(orow + d) = wv; } }
    __syncthreads();
}

constexpr float SB_THR = -200.f;
DI void sb_unit(const Ctx& C, LAS char* lds, bool sample, int b, int hh, int qb) {
    int tid_ = threadIdx.x; asm volatile("" : "+v"(tid_));
    const int tid = tid_, lane = tid & 63, r = lane & 31, h = lane >> 5, w = __builtin_amdgcn_readfirstlane(tid >> 6);
    const bool active = sample ? (w < 2) : true;
    const int ncache = sample ? 32 : 0;
    const int tokbase = sample ? MP + b * DSEQ : b * SEQ;
    const int cbase = b * PAST;
    const int Tmax = sample ? 32 : 4 * qb + 3;
    const int qrel = sample ? 32 * w : 256 * qb + 32 * w;
    const int Tw = sample ? 32 : (qrel >> 6);
    const int qi = (qrel & 63) + r;
    const int qrow = tokbase + (active ? qrel : 0) + r;
    LAS unsigned* flags = (LAS unsigned*)(lds + 32768);
    bf16x8 qf[4];
#pragma unroll
    for (int ds = 0; ds < 4; ++ds) qf[ds] = *(const bf16x8*)(C.U + (size_t)qrow * NIN + 1536 + hh * 64 + 16 * ds + 8 * h);
    unsigned kaddr[4];
    { const unsigned x = ((r & 3u) << 2) | ((r >> 2) & 3u);
#pragma unroll
      for (int ds = 0; ds < 4; ++ds) kaddr[ds] = 256u * r + 16u * ((unsigned)(2 * ds + h) ^ x); }
    unsigned vaddr[2][2];
    { const unsigned blk = (lane >> 4) & 1, q = (lane & 15) >> 2, p = lane & 3;
#pragma unroll
      for (int t = 0; t < 2; ++t)
#pragma unroll
          for (int c = 0; c < 2; ++c) vaddr[t][c] = off_b(8 * t + 4 * h + q, 4 * (c + 2) + 2 * blk + (p >> 1)) + 8 * (p & 1); }
    bf16x8 tri[2];
#pragma unroll
    for (int s = 0; s < 2; ++s)
#pragma unroll
        for (int j = 0; j < 8; ++j) tri[s][j] = ((16 * s + 8 * (j >> 2) + 4 * h + (j & 3)) > r) ? (short)0x3F80 : (short)0;
    const int srow = tid >> 4, sch = tid & 15;
    const unsigned sdst0 = off_b(srow, sch), sdst1 = off_b(srow + 32, sch);
    const int scol = (sch < 8) ? (2048 + hh * 64 + sch * 8) : (2560 + hh * 64 + (sch - 8) * 8);
    const float* csrc = (sch < 8) ? C.csk : C.csv;
    u32x4 st[4];
    auto issue = [&](int t) {
        if (t < ncache) {
            const size_t o0 = (size_t)(cbase + 64 * t + srow) * 512 + hh * 64 + (sch & 7) * 8, o1 = o0 + (size_t)32 * 512;
            st[0] = *(const u32x4*)(csrc + o0); st[1] = *(const u32x4*)(csrc + o0 + 4); st[2] = *(const u32x4*)(csrc + o1); st[3] = *(const u32x4*)(csrc + o1 + 4);
        } else {
            const bf16_t* g0 = C.U + (size_t)(tokbase + 64 * (t - ncache) + srow) * NIN + scol;
            st[0] = *(const u32x4*)g0; st[1] = *(const u32x4*)(g0 + (size_t)32 * NIN);
        }
    };
    auto commit = [&](int t, int buf) {
        LAS char* img = lds + buf * 16384;
        if (t < ncache) { *(LAS u32x4*)(img + sdst0) = cvt8(st[0], st[1]); *(LAS u32x4*)(img + sdst1) = cvt8(st[2], st[3]); }
        else { *(LAS u32x4*)(img + sdst0) = st[0]; *(LAS u32x4*)(img + sdst1) = st[1]; }
    };
    const float c1 = 0.125f * LOG2E;
    f32x16 o[2];
#pragma unroll
    for (int dt = 0; dt < 2; ++dt)
#pragma unroll
        for (int i = 0; i < 16; ++i) o[dt][i] = 0.f;
    float R = 0.f;

    issue(Tmax); commit(Tmax, 0); __syncthreads();
    int cur = 0;
    for (int t = Tmax; t >= 0; --t) {
        if (t > 0) issue(t - 1);
        unsigned done = active ? 0u : 1u;
        if (active && t <= Tw) {
            const LAS char* img = lds + cur * 16384;
            const bool diag = (t == Tw);
            bf16x8 P[4];
            float carry = R;
            float tsum = 0.f;
#define SB_HALF(KT) { \
                f32x16 z; _Pragma("unroll") for (int i = 0; i < 16; ++i) z[i] = 0.f; \
                _Pragma("unroll") for (int ds = 0; ds < 4; ++ds) { const bf16x8 kf = *(const LAS bf16x8*)(img + kaddr[ds] + 8192 * (KT)); z = MFMA32(kf, qf[ds], z); } \
                f32x16 ln, hi_f; float sm = 0.f; \
                _Pragma("unroll") for (int i = 0; i < 16; ++i) { const float z2 = z[i] * c1; const float e = __builtin_amdgcn_exp2f(-fabsf(z2)); \
                    const float sp = fmaxf(z2, 0.f) + __builtin_amdgcn_logf(1.f + e); \
                    const bool earlier = !diag || ((32 * (KT) + (i & 3) + 8 * (i >> 2) + 4 * h) < qi); \
                    ln[i] = earlier ? -sp : 0.f; z[i] = earlier ? (z2 - sp) : -1e30f; sm += ln[i]; } \
                sm = xswap_add(sm); \
                u32x4 ph0, ph1, pl0, pl1; \
                _Pragma("unroll") for (int k2 = 0; k2 < 4; ++k2) { \
                    const unsigned a = cvtpk(ln[2 * k2], ln[2 * k2 + 1]); ph0[k2] = a; pl0[k2] = cvtpk(ln[2 * k2] - __uint_as_float(a << 16), ln[2 * k2 + 1] - __uint_as_float(a & 0xffff0000u)); \
                    const unsigned bq = cvtpk(ln[8 + 2 * k2], ln[9 + 2 * k2]); ph1[k2] = bq; pl1[k2] = cvtpk(ln[8 + 2 * k2] - __uint_as_float(bq << 16), ln[9 + 2 * k2] - __uint_as_float(bq & 0xffff0000u)); } \
                f32x16 bt; _Pragma("unroll") for (int i = 0; i < 16; ++i) bt[i] = carry; \
                bt = MFMA32(tri[0], __builtin_bit_cast(bf16x8, ph0), bt); bt = MFMA32(tri[1], __builtin_bit_cast(bf16x8, ph1), bt); \
                bt = MFMA32(tri[0], __builtin_bit_cast(bf16x8, pl0), bt); bt = MFMA32(tri[1], __builtin_bit_cast(bf16x8, pl1), bt); \
                _Pragma("unroll") for (int i = 0; i < 16; ++i) z[i] = __builtin_amdgcn_exp2f(z[i] + bt[i]); \
                P[2 * (KT)] = pack8<0>(z); P[2 * (KT) + 1] = pack8<1>(z); \
                carry += sm; tsum += sm; }
            SB_HALF(1)
            SB_HALF(0)
#undef SB_HALF
            R += tsum;
#pragma unroll
            for (int dt = 0; dt < 2; ++dt)
#pragma unroll
                for (int ks = 0; ks < 4; ++ks) { const s16x4 lo = trr(img + vaddr[0][dt] + 4096 * ks), hi = trr(img + vaddr[1][dt] + 4096 * ks);
                    o[dt] = MFMA32(cat8(lo, hi), P[ks], o[dt]); }
            done = __all(R < SB_THR) ? 1u : 0u;
        }
        if (lane == 0) flags[(cur << 3) + w] = done;
        if (t > 0) commit(t - 1, cur ^ 1);
        __syncthreads();
        bool alld = true;
#pragma unroll
        for (int k = 0; k < 8; ++k) alld = alld && (flags[(cur << 3) + k] != 0u);
        cur ^= 1;
        if (alld) break;
    }
    if (active) {
        bf16_t* orow = C.MIX + (size_t)qrow * DM + 512 + hh * 64;
#pragma unroll
        for (int dt = 0; dt < 2; ++dt)
#pragma unroll
            for (int g = 0; g < 4; ++g) { const int d = 32 * dt + 8 * g + 4 * h;
                u32x2 wv; wv.x = cvtpk(o[dt][4 * g], o[dt][4 * g + 1]); wv.y = cvtpk(o[dt][4 * g + 2], o[dt][4 * g + 3]);
                *(u32x2*)(orow + d) = wv; }
    }
    __syncthreads();
}
constexpr int N_DS = 64, N_DP = 512, N_SP = 512, N_SS = 128, N_UNITS = N_DS + N_DP + N_SP + N_SS;
}

#define XB_TMO      128
#define XB_XCNT(j)  (256  + 64 * (j))
#define XB_XSUB(j)  (1280 + 64 * (j))
#define XB_XGEN(j)  (2304 + 64 * (j))
#define XB_TOP      3328
#define XB_TOPGEN   3392
#define XCD_BAR_WORDS 3456
#define XB_SPIN_CAP (1u << 18)

__device__ __forceinline__ unsigned xb_ld(unsigned* p)              { return __hip_atomic_load(p, __ATOMIC_RELAXED, __HIP_MEMORY_SCOPE_AGENT); }
__device__ __forceinline__ unsigned xb_add(unsigned* p, unsigned v) { return __hip_atomic_fetch_add(p, v, __ATOMIC_RELAXED, __HIP_MEMORY_SCOPE_AGENT); }
__device__ __forceinline__ unsigned xb_xcc_id() { return (unsigned)__builtin_amdgcn_s_getreg((3 << 11) | 20) & 0xFu; }
#define XB_SPIN(cond, bar) do { unsigned _sp = 0; while (cond) { __builtin_amdgcn_s_sleep(1); \
    if ((++_sp & 255u) == 0u) { if (xb_ld(&(bar)[XB_TMO])) break; if (_sp > XB_SPIN_CAP) { atomicAdd(&(bar)[XB_TMO], 1u); break; } } } } while (0)

struct XcdBarrier {
    unsigned* bar; unsigned x;
    volatile LAS unsigned* st;
};

__device__ __forceinline__ XcdBarrier xcd_barrier_post(unsigned* bar, volatile LAS unsigned* st) {
    XcdBarrier b; b.bar = bar; b.x = xb_xcc_id(); b.st = st;
    if (threadIdx.x == 0) (void)xb_add(&bar[XB_XCNT(b.x)], 1u);
    return b;
}
__device__ __forceinline__ void xcd_barrier_complete(unsigned* bar, unsigned x, unsigned& nloc, unsigned& nx) {
    const unsigned G = gridDim.x * gridDim.y * gridDim.z;
    unsigned sum, cnt, mine, sp = 0u;
    for (;;) {
        sum = 0u; cnt = 0u; mine = 0u;
#pragma unroll
        for (unsigned j = 0; j < 16; ++j) { const unsigned c = xb_ld(&bar[XB_XCNT(j)]); sum += c; cnt += (c > 0u) ? 1u : 0u; mine = (j == x) ? c : mine; }
        if (sum == G) break;
        __builtin_amdgcn_s_sleep(1);
        if ((++sp & 255u) == 0u) { if (xb_ld(&bar[XB_TMO])) break; if (sp > XB_SPIN_CAP) { atomicAdd(&bar[XB_TMO], 1u); break; } }
    }
    nloc = mine > 0u ? mine : 1u; nx = cnt > 0u ? cnt : 1u;
}

__device__ __forceinline__ void xcd_barrier(const XcdBarrier& b) {
    asm volatile("s_waitcnt vmcnt(0)" ::: "memory");
    __syncthreads();
    if (threadIdx.x == 0) {
        unsigned* bar = b.bar;
        __builtin_amdgcn_s_waitcnt(0);
        unsigned nloc = b.st[0], nx = b.st[1];
        if (nloc == 0u) { xcd_barrier_complete(bar, b.x, nloc, nx); b.st[0] = nloc; b.st[1] = nx; }
        const unsigned old = xb_add(&bar[XB_XSUB(b.x)], 1u);
        const unsigned gen = old / nloc;
        if (old + 1u == (gen + 1u) * nloc) {
            __builtin_amdgcn_fence(__ATOMIC_RELEASE, "agent");
            asm volatile("s_waitcnt vmcnt(0)" ::: "memory");
            const unsigned og = xb_add(&bar[XB_TOP], 1u);
            const unsigned tg = og / nx;
            if (og + 1u == (tg + 1u) * nx) xb_add(&bar[XB_TOPGEN], 1u);
            else XB_SPIN(xb_ld(&bar[XB_TOPGEN]) == tg, bar);
            __builtin_amdgcn_fence(__ATOMIC_ACQUIRE, "agent");
            xb_add(&bar[XB_XGEN(b.x)], 1u);
            asm volatile("s_waitcnt vmcnt(0)" ::: "memory");
        } else {
            XB_SPIN(xb_ld(&bar[XB_XGEN(b.x)]) == gen, bar);
            __builtin_amdgcn_fence(__ATOMIC_ACQUIRE, "agent");
            asm volatile("s_waitcnt vmcnt(0)" ::: "memory");
        }
    }
    __syncthreads();
}

struct Params { const float* in[23]; float* out; unsigned char* ws; };

__global__ void __launch_bounds__(512, 2) fwd_megakernel(Params p) {
    extern __shared__ __attribute__((aligned(16))) unsigned char lds_raw[];
    cg::grid_group grid = cg::this_grid();
    LAS unsigned char* lds = (LAS unsigned char*)lds_raw;
    const int tid = threadIdx.x, lane = tid & 63, wave = __builtin_amdgcn_readfirstlane(tid >> 6);
    const int G = gridDim.x, NGW = G * 8, gw = wave * G + (int)blockIdx.x;
    unsigned char* ws = p.ws;
    unsigned* ctl = (unsigned*)(ws + WS_CTL);
    float* mod = (float*)(ws + WS_MOD);
    bf16_t* Win_t = (bf16_t*)(ws + WS_WIN); bf16_t* Wout_t = (bf16_t*)(ws + WS_WOUT); bf16_t* Wup_t = (bf16_t*)(ws + WS_WUP); bf16_t* Wdn_t = (bf16_t*)(ws + WS_WDN);
    bf16_t* XN = (bf16_t*)(ws + WS_XN); bf16_t* U = (bf16_t*)(ws + WS_U); bf16_t* MIX = (bf16_t*)(ws + WS_MIX); bf16_t* HB = (bf16_t*)(ws + WS_HB);
    float* Y = (float*)(ws + WS_Y);
    const float* xp = p.in[0]; const float* xs = p.in[1];
    volatile LAS unsigned* bst = (volatile LAS unsigned*)(lds + LDS_MISC + 32);
    if (tid < 2) bst[tid] = 0u;
    __syncthreads();
    XcdBarrier bar = xcd_barrier_post(ctl + CW_BAR, bst);

    {
        if (blockIdx.x == 0 && tid < 8) ctl[tid] = 0u;
        LAS float* scr = (LAS float*)(lds + wave * 16384);
        constexpr int I_MOD = NMOD / 32, I_IN = (DM / 64) * (NIN / 32), I_OUT = (DM / 64) * (DM / 32), I_UP = (DM / 64) * (DFF / 32), I_DN = (DFF / 64) * (DM / 32);
        constexpr int NITEMS = I_IN + I_OUT + I_UP + I_DN;
        for (int rep = 0; rep < REP_P0; ++rep) {
        for (int it = (int)blockIdx.x; it < I_MOD; it += G) p0_modulate_block(p.in[2], p.in[3], p.in[8], p.in[9], mod, lds, it, tid, lane, wave);
        for (int it = gw; it < NITEMS; it += NGW) {
            int r = it;
            if (r < I_IN) { p0_transpose_item(p.in[12], DM, NIN, Win_t, scr, r, lane); continue; } r -= I_IN;
            if (r < I_OUT) { p0_transpose_item(p.in[18], DM, DM, Wout_t, scr, r, lane); continue; } r -= I_OUT;
            if (r < I_UP) { p0_transpose_item(p.in[21], DM, DFF, Wup_t, scr, r, lane); continue; } r -= I_UP;
            p0_transpose_item(p.in[22], DFF, DM, Wdn_t, scr, r, lane);
        }
        }
    }
    grid.sync();
    for (int rep = 0; rep < REP_SYNC; ++rep) xcd_barrier(bar);
    for (int rep = 0; rep < REP_ROW; ++rep)
    for (int row = gw; row < MT; row += NGW) {
        const float* xr = row < MP ? xp + (size_t)row * DM : xs + (size_t)(row - MP) * DM;
        p1_row(xr, mod, p.in[10], XN + (size_t)row * DM, row_bi(row), lane);
    }
    xcd_barrier(bar);
    {
        pg8::Gemm g{XN, Win_t, MT, NIN, DM}; pg8::StaticOrder S; S.init(MT, NIN, G, (int)blockIdx.x);
        pg8::EpiQKV E{U, p.out};
        pg8::gemm_phase<pg8::EpiQKV, pg8::StaticOrder, true, true>(lds, g, S, E);
#if REP_GEMM > 1
        __syncthreads(); pg8::gemm_phase<pg8::EpiQKV, pg8::StaticOrder, true, true>(lds, g, S, E);
#endif
    }
    xcd_barrier(bar);
#ifndef NO_ATT
    {
        att::Ctx C; C.U = U; C.MIX = MIX; C.cdk = p.in[4]; C.cdv = p.in[5]; C.csk = p.in[6]; C.csv = p.in[7]; C.subg = p.in[17];
        { const float a = p.in[13][lane] * p.in[14][lane], bq = p.in[15][lane] * p.in[16][lane];
          C.lam = __expf(wave_sum(a)) - __expf(wave_sum(bq)) + 0.2f; }
        LAS unsigned* qword = (LAS unsigned*)(lds + LDS_MISC);
        for (int rep = 0; rep < REP_ATT; ++rep)
        for (;;) {
            if (tid == 0) qword[0] = atomicAdd(ctl + rep, 1u);
            __syncthreads();
            const int idx = (int)qword[0];
            __syncthreads();
            if (idx >= att::N_UNITS) break;
            bool is_diff, sample; int ub, uh, uu;
            if (idx < att::N_DS) { is_diff = true; sample = true; ub = idx >> 2; uh = idx & 3; uu = 0; }
            else if (idx < att::N_DS + att::N_DP) { const int j = idx - att::N_DS; is_diff = true; sample = false; ub = (j & 31) >> 2; uh = j & 3; uu = 15 - (j >> 5); }
            else if (idx < att::N_DS + att::N_DP + att::N_SP) { const int j = idx - att::N_DS - att::N_DP; is_diff = false; sample = false; ub = (j & 63) >> 3; uh = j & 7; uu = 7 - (j >> 6); }
            else { const int j = idx - att::N_DS - att::N_DP - att::N_SP; is_diff = false; sample = true; ub = j >> 3; uh = j & 7; uu = 0; }
            if (is_diff) att::diff_unit(C, (LAS char*)lds, sample, ub, uh, uu);
            else att::sb_unit(C, (LAS char*)lds, sample, ub, uh, uu);
        }
    }
#endif
    xcd_barrier(bar);
    {
        pg8::Gemm g{MIX, Wout_t, MT, DM, DM}; pg8::StaticOrder S; S.init(MT, DM, G, (int)blockIdx.x);
        pg8::EpiF32 E{Y, DM};
        pg8::gemm_phase<pg8::EpiF32, pg8::StaticOrder, true, true>(lds, g, S, E);
#if REP_GEMM > 1
        __syncthreads(); pg8::gemm_phase<pg8::EpiF32, pg8::StaticOrder, true, true>(lds, g, S, E);
#endif
    }
    xcd_barrier(bar);
    for (int rep = 0; rep < REP_ROW; ++rep)
    for (int row = gw; row < MT; row += NGW) {
        const float* xr = row < MP ? xp + (size_t)row * DM : xs + (size_t)(row - MP) * DM;
        p5_row(xr, Y + (size_t)row * DM, mod, p.in[11], p.in[19], p.out + (size_t)row * DM, XN + (size_t)row * DM, row_bi(row), lane);
    }
    xcd_barrier(bar);
    {
        pg8::Gemm g{XN, Wup_t, MT, DFF, DM}; pg8::StaticOrder S; S.init(MT, DFF, G, (int)blockIdx.x);
        pg8::EpiRelu2 E{HB, DFF};
        pg8::gemm_phase<pg8::EpiRelu2, pg8::StaticOrder, true, true>(lds, g, S, E);
#if REP_GEMM > 1
        __syncthreads(); pg8::gemm_phase<pg8::EpiRelu2, pg8::StaticOrder, true, true>(lds, g, S, E);
#endif
    }
    xcd_barrier(bar);
    {
        pg8::Gemm g{HB, Wdn_t, MT, DM, DFF}; pg8::StaticOrder S; S.init(MT, DM, G, (int)blockIdx.x);
        pg8::EpiF32 E{Y, DM};
        pg8::gemm_phase<pg8::EpiF32, pg8::StaticOrder, true, true>(lds, g, S, E);
#if REP_GEMM > 1
        __syncthreads(); pg8::gemm_phase<pg8::EpiF32, pg8::StaticOrder, true, true>(lds, g, S, E);
#endif
    }
    xcd_barrier(bar);
    for (int row = gw; row < MT; row += NGW)
        p8_row(Y + (size_t)row * DM, mod, p.in[20], p.out + (size_t)row * DM, row_bi(row), lane);
}

extern "C" void kernel_launch(void* const* d_in, const int* in_sizes, int n_in, void* d_out, int out_size, void* d_ws, size_t ws_size, hipStream_t stream) {
    static int grid_blocks = 0;
    if (grid_blocks == 0) {
        if (n_in != 23 || ws_size < WS_END) { fprintf(stderr, "kernel_launch: unexpected n_in %d / ws_size %zu\n", n_in, ws_size); grid_blocks = -1; return; }
        int dev = 0, cus = 0, per_cu = 0;
        hipGetDevice(&dev);
        hipDeviceGetAttribute(&cus, hipDeviceAttributeMultiprocessorCount, dev);
        hipFuncSetAttribute((const void*)fwd_megakernel, hipFuncAttributeMaxDynamicSharedMemorySize, LDS_BYTES);
        hipOccupancyMaxActiveBlocksPerMultiprocessor(&per_cu, (const void*)fwd_megakernel, 512, LDS_BYTES);
        (void)hipGetLastError();
        if (per_cu < 1) per_cu = 1;
        grid_blocks = cus * 1;
    }
    if (grid_blocks < 0) return;
    if (hipMemsetAsync((char*)d_ws + WS_CTL, 0, CTL_ZERO_BYTES, stream) != hipSuccess) { fprintf(stderr, "kernel_launch: memset failed\n"); return; }
    Params p{};
    for (int i = 0; i < 23; ++i) p.in[i] = (const float*)d_in[i];
    p.out = (float*)d_out; p.ws = (unsigned char*)d_ws;
    void* args[] = {&p};
    hipError_t e = hipLaunchCooperativeKernel((const void*)fwd_megakernel, dim3(grid_blocks), dim3(512), args, LDS_BYTES, stream);
    if (e != hipSuccess) fprintf(stderr, "cooperative launch failed: %s (grid %d)\n", hipGetErrorString(e), grid_blocks);
}
```

```cpp
#include <hip/hip_runtime.h>
#include <hip/hip_cooperative_groups.h>
#include <cstdio>
#include <cstdint>
namespace cg = cooperative_groups;
namespace pg8 {
#define PG8_LAS __attribute__((address_space(3)))
typedef unsigned short bf16_t;
typedef short bf16x8 __attribute__((ext_vector_type(8)));
typedef float f32x4 __attribute__((ext_vector_type(4)));
typedef unsigned u32x4 __attribute__((ext_vector_type(4)));
constexpr int BM = 256, BK = 64, HALF = 128, HTB = HALF * BK * 2  , STAGE_BYTES = 8 * HTB, NXCD = 8, WGM = 8;

__host__ __device__ __forceinline__ int lds_byte(int r, int c) { const int st = (r >> 4) * 2 + (c >> 5), rr = r & 15, cc = c & 31, ob = rr * 64 + cc * 2; return st * 1024 + (ob ^ (((ob >> 9) & 1) << 5)); }
__host__ __device__ __forceinline__ void stage_rc(int b, int& R, int& C) { const int st = b / 1024, sb = b % 1024, swz = sb ^ (((sb >> 9) & 1) << 5); R = (st >> 1) * 16 + swz / 64; C = (st & 1) * 32 + (swz % 64) / 2; }
__host__ __device__ __forceinline__ int perm32(int rho) { const int n = rho >> 4, i = rho & 15; return 8 * (i >> 2) + 4 * n + (i & 3); }

struct Unit { int pm, pn, k0, kn, ks; };
struct Gemm { const bf16_t* A; const bf16_t* Bt; int M, N, K; };

struct StaticOrder {
    int nM, nN, nwg, G, c, kt;
    __host__ __device__ void init(int M, int N, int G_, int c_, int K_) { nM = M / BM; nN = N / BM; nwg = nM * nN; G = G_; c = c_; kt = K_ / BK; }
    __host__ __device__ bool next(int i, Unit& u) const {
        const long L = (long)i * G + c; if (L >= nwg) return false;
        int wgid = (int)L; { const int q = nwg / NXCD, r = nwg % NXCD, xcd = wgid % NXCD, off = wgid / NXCD; wgid = (xcd < r ? xcd * (q + 1) : r * (q + 1) + (xcd - r) * q) + off; }
        const int nig = WGM * nN, gid = wgid / nig, fm = gid * WGM, gsz = (nM - fm) < WGM ? (nM - fm) : WGM;
        u.pm = fm + ((wgid % nig) % gsz); u.pn = (wgid % nig) / gsz; u.k0 = 0; u.kn = kt; u.ks = -1; return true;
    }
    __device__ __forceinline__ void a_ready(const Unit&) const {}
    __device__ __forceinline__ void done(const Unit&) const {}
};

struct SplitOrder {
    StaticOrder so; int pm0, nN, nsplit, kext, npieces, G, c;
    __host__ __device__ void init(int M0, int M, int N, int G_, int c_, int K_, int nsplit_) { so.init(M0, N, G_, c_, K_); pm0 = M0 / BM; nN = N / BM; nsplit = nsplit_; kext = K_ / nsplit_; npieces = ((M - M0) / BM) * nN * nsplit_; G = G_; c = c_; }
    __host__ __device__ bool next(int i, Unit& u) const {
        if (so.next(i, u)) return true;
        const int nmine = (so.nwg > c) ? (so.nwg - c + G - 1) / G : 0;
        const long L = (long)(i - nmine) * G + c; if (L >= npieces) return false;
        const int tile = (int)L / nsplit, ks = (int)L % nsplit;
        u.pm = pm0 + tile / nN; u.pn = tile % nN; u.k0 = ks * kext; u.kn = kext / BK; u.ks = ks; return true;
    }
    __device__ __forceinline__ void a_ready(const Unit&) const {}
    __device__ __forceinline__ void done(const Unit&) const {}
};

__device__ __forceinline__ unsigned cvt_pk_bf16(float lo, float hi) { unsigned r; asm volatile("v_cvt_pk_bf16_f32 %0, %1, %2" : "=v"(r) : "v"(lo), "v"(hi)); return r; }
typedef float f32x2 __attribute__((ext_vector_type(2)));
__device__ __forceinline__ f32x2 gelu_pk(f32x2 v) {
    const f32x2 av = __builtin_elementwise_abs(v), d = av * 0.2316418882f + 1.0f;
    f32x2 t; t.x = __builtin_amdgcn_rcpf(d.x); t.y = __builtin_amdgcn_rcpf(d.y);
    f32x2 q = t * 0.5307027145f + (-0.7265760135f); q = q * t + 0.7107068705f; q = q * t + (-0.142248368f); q = q * t + 0.127414796f; q = q * t;
    const f32x2 s = (v * v) * (-0.72134752044f);
    f32x2 e; e.x = __builtin_amdgcn_exp2f(s.x); e.y = __builtin_amdgcn_exp2f(s.y);
    const f32x2 m = v * (q * e), r = v - m;
    f32x2 o; o.x = v.x < 0.f ? m.x : r.x; o.y = v.y < 0.f ? m.y : r.y; return o;
}

template <int ACT  > struct EpiBf16 {
    static constexpr bool PERM = true, AFTER_DRAIN = false; static_assert(ACT == 0 || ACT == 1, "EpiBf16: ACT is 0 (none) or 1 (gelu_pk)");
    bf16_t* O; int ldc; const float* bias; int split_cols; size_t split_stride; float scale0;
    __device__ __forceinline__ void operator()(const f32x4 (&acc)[2][2][4][2], const Unit& u, int wr, int wc, int fr, int fq) const {
        const int row0 = u.pm * BM + wr * 64 + fr; int colt = u.pn * BM; bf16_t* base = O;
        float sc = 1.f; if (split_cols) { const int t = colt / split_cols; base += (size_t)t * split_stride; colt -= t * split_cols; if (t == 0) sc = scale0; }
        const int col0 = colt + wc * 32 + 8 * fq, bcol0 = u.pn * BM + wc * 32 + 8 * fq;
        f32x4 bv[2][2];
#pragma unroll
        for (int bj = 0; bj < 2; ++bj)
#pragma unroll
            for (int n = 0; n < 2; ++n) bv[bj][n] = bias ? *(const f32x4*)(bias + bcol0 + bj * HALF + 4 * n) : (f32x4){0.f, 0.f, 0.f, 0.f};
#pragma unroll
        for (int ai = 0; ai < 2; ++ai)
#pragma unroll
            for (int m = 0; m < 4; ++m) { bf16_t* rowp = base + (size_t)(row0 + ai * HALF + m * 16) * ldc + col0;
#pragma unroll
                for (int bj = 0; bj < 2; ++bj) { f32x4 v0 = acc[ai][bj][m][0] + bv[bj][0], v1 = acc[ai][bj][m][1] + bv[bj][1];
                    if (ACT == 1) { f32x2 a = gelu_pk((f32x2){v0[0], v0[1]}), b = gelu_pk((f32x2){v0[2], v0[3]}), c = gelu_pk((f32x2){v1[0], v1[1]}), d = gelu_pk((f32x2){v1[2], v1[3]});
                        v0 = (f32x4){a.x, a.y, b.x, b.y}; v1 = (f32x4){c.x, c.y, d.x, d.y}; }
                    v0 = v0 * sc; v1 = v1 * sc; u32x4 w; w.x = cvt_pk_bf16(v0[0], v0[1]); w.y = cvt_pk_bf16(v0[2], v0[3]); w.z = cvt_pk_bf16(v1[0], v1[1]); w.w = cvt_pk_bf16(v1[2], v1[3]);
                    *(u32x4*)(rowp + bj * HALF) = w; } }
    }
};

template <class Epi, class Sched, bool ALIGN_EPI = false, bool SP2 = false>
__device__ __forceinline__ void gemm_phase(PG8_LAS unsigned char* lds, const Gemm g, const Sched& S, const Epi& E) {
    const int tid = threadIdx.x, wid = __builtin_amdgcn_readfirstlane(tid >> 6), lane = tid & 63, wr = wid >> 2, wc = wid & 3, fr = lane & 15, fq = lane >> 4;
    const int K = g.K;
    unsigned voffA[2], voffB[2];
#pragma unroll
    for (int i = 0; i < 2; ++i) { int R, C; stage_rc(tid * 16 + i * 8192, R, C); const int Rb = Epi::PERM ? ((R & ~31) + perm32(R & 31)) : R;
        voffA[i] = (unsigned)(R * K + C) * 2u; voffB[i] = (unsigned)(Rb * K + C) * 2u; }
    const size_t kstep = (size_t)(BK * 2);
    const size_t hstep = (size_t)HALF * K * 2;
    const size_t tstep = 2 * hstep;
    const unsigned ldsw = (unsigned)wid * 1024u;
    const int aoff = lds_byte(wr * 64 + fr, fq * 8), boff = lds_byte(wc * 32 + fr, fq * 8);
#define PG8_SA(b, h) (((b) * 2 + (h)) * HTB)
#define PG8_SB(b, h) ((4 + (b) * 2 + (h)) * HTB)
#define PG8_STAGE(bufoff, gbase, voff) do { _Pragma("unroll") for (int _i = 0; _i < 2; ++_i) \
        __builtin_amdgcn_global_load_lds((const unsigned*)((const char*)(gbase) + (voff)[_i]), (PG8_LAS unsigned*)(lds + (bufoff) + ldsw + _i * 8192), 16, 0, 0); } while (0)
#define PG8_LDA(dst, b, h) do { _Pragma("unroll") for (int m = 0; m < 4; ++m) _Pragma("unroll") for (int k = 0; k < 2; ++k) dst[m][k] = *(const PG8_LAS bf16x8*)(lds + PG8_SA(b, h) + aoff + m * 2048 + k * 1024); } while (0)
#define PG8_LDB(dst, b, h) do { _Pragma("unroll") for (int n = 0; n < 2; ++n) _Pragma("unroll") for (int k = 0; k < 2; ++k) dst[n][k] = *(const PG8_LAS bf16x8*)(lds + PG8_SB(b, h) + boff + n * 2048 + k * 1024); } while (0)
#define PG8_MMA(ai, bj, At, Bt) do { __builtin_amdgcn_s_setprio(1); _Pragma("unroll") for (int m = 0; m < 4; ++m) _Pragma("unroll") for (int n = 0; n < 2; ++n) _Pragma("unroll") for (int k = 0; k < 2; ++k) \
        acc[ai][bj][m][n] = __builtin_amdgcn_mfma_f32_16x16x32_bf16(Bt[n][k], At[m][k], acc[ai][bj][m][n], 0, 0, 0); __builtin_amdgcn_s_setprio(0); } while (0)
#define PG8_WAIT_V(n) asm volatile("s_waitcnt vmcnt(" #n ")" ::: "memory")
#define PG8_WAIT_L(n) asm volatile("s_waitcnt lgkmcnt(" #n ")" ::: "memory")
#define PG8_BAR __builtin_amdgcn_s_barrier()
#define PG8_SCHED __builtin_amdgcn_sched_barrier(0)
    Unit cur, nxt; int ui = 0;
    if (!S.next(0, cur)) return;
    f32x4 acc[2][2][4][2];
#pragma unroll
    for (int a = 0; a < 2; ++a)
#pragma unroll
        for (int b = 0; b < 2; ++b)
#pragma unroll
            for (int m = 0; m < 4; ++m)
#pragma unroll
                for (int n = 0; n < 2; ++n) acc[a][b][m][n] = (f32x4){0.f, 0.f, 0.f, 0.f};
    bf16x8 At[4][2], B0[2][2], B1[2][2];
    const char* cA = (const char*)g.A + (size_t)cur.pm * tstep + (size_t)cur.k0 * 2; const char* cB = (const char*)g.Bt + (size_t)cur.pn * tstep + (size_t)cur.k0 * 2;
    S.a_ready(cur);
    if constexpr (SP2) {
        PG8_STAGE(PG8_SB(0, 0), cB, voffB); PG8_STAGE(PG8_SB(0, 1), cB + hstep, voffB); PG8_STAGE(PG8_SA(0, 0), cA, voffA); PG8_STAGE(PG8_SA(0, 1), cA + hstep, voffA);
        if (wr == 1) PG8_BAR;
        PG8_WAIT_V(2); PG8_BAR;
        PG8_STAGE(PG8_SB(1, 0), cB + kstep, voffB); PG8_STAGE(PG8_SA(1, 0), cA + kstep, voffA); PG8_STAGE(PG8_SB(1, 1), cB + hstep + kstep, voffB);
        PG8_WAIT_V(6); PG8_BAR;
    } else {
        PG8_STAGE(PG8_SB(0, 0), cB, voffB); PG8_STAGE(PG8_SA(0, 0), cA, voffA); PG8_STAGE(PG8_SB(0, 1), cB + hstep, voffB); PG8_STAGE(PG8_SA(0, 1), cA + hstep, voffA);
        if (wr == 1) PG8_BAR;
        PG8_WAIT_V(4); PG8_BAR;
        PG8_STAGE(PG8_SB(1, 0), cB + kstep, voffB); PG8_STAGE(PG8_SA(1, 0), cA + kstep, voffA); PG8_STAGE(PG8_SB(1, 1), cB + hstep + kstep, voffB);
        PG8_WAIT_V(6); PG8_BAR;
    }
    for (;;) {
        const bool has_next = S.next(ui + 1, nxt);
        const char* nA = has_next ? (const char*)g.A + (size_t)nxt.pm * tstep + (size_t)nxt.k0 * 2 : cA; const char* nB = has_next ? (const char*)g.Bt + (size_t)nxt.pn * tstep + (size_t)nxt.k0 * 2 : cB;
        const int nt = cur.kn;
        for (int t = 0; t < nt; t += 2) {
            const bool last = (t == nt - 2);
            const char* a1 = cA + (size_t)(t + 1) * kstep;
            const char* a2 = last ? nA : cA + (size_t)(t + 2) * kstep; const char* b2 = last ? nB : cB + (size_t)(t + 2) * kstep;
            const char* a3 = a2 + kstep; const char* b3 = b2 + kstep;
            if (last && has_next) S.a_ready(nxt);
            if constexpr (SP2) {
            PG8_LDB(B0, 0, 0); PG8_LDB(B1, 0, 1); PG8_SCHED; PG8_LDA(At, 0, 0); PG8_STAGE(PG8_SA(1, 1), a1 + hstep, voffA);
            PG8_WAIT_V(8); PG8_WAIT_L(0); PG8_BAR; PG8_MMA(0, 0, At, B0); PG8_MMA(0, 1, At, B1); PG8_BAR; PG8_SCHED;
            PG8_LDA(At, 0, 1); PG8_STAGE(PG8_SB(0, 0), b2, voffB); PG8_STAGE(PG8_SB(0, 1), b2 + hstep, voffB); PG8_STAGE(PG8_SA(0, 0), a2, voffA);
            PG8_WAIT_V(8); PG8_WAIT_L(0); PG8_BAR; PG8_MMA(1, 0, At, B0); PG8_MMA(1, 1, At, B1); PG8_BAR; PG8_SCHED;
            PG8_LDB(B0, 1, 0); PG8_LDB(B1, 1, 1); PG8_SCHED; PG8_LDA(At, 1, 0); PG8_STAGE(PG8_SA(0, 1), a2 + hstep, voffA);
            PG8_WAIT_V(8); PG8_WAIT_L(0); PG8_BAR; PG8_MMA(0, 0, At, B0); PG8_MMA(0, 1, At, B1); PG8_BAR; PG8_SCHED;
            PG8_LDA(At, 1, 1); PG8_STAGE(PG8_SB(1, 0), b3, voffB); PG8_STAGE(PG8_SB(1, 1), b3 + hstep, voffB); PG8_STAGE(PG8_SA(1, 0), a3, voffA);
            PG8_WAIT_V(8); PG8_WAIT_L(0); PG8_BAR; PG8_MMA(1, 0, At, B0); PG8_MMA(1, 1, At, B1); PG8_BAR; PG8_SCHED;
            } else {
            PG8_LDB(B0, 0, 0); PG8_SCHED; PG8_LDA(At, 0, 0); PG8_STAGE(PG8_SA(1, 1), a1 + hstep, voffA);
            PG8_WAIT_L(8); PG8_BAR; PG8_WAIT_L(0); PG8_MMA(0, 0, At, B0); PG8_BAR; PG8_SCHED;
            PG8_LDB(B1, 0, 1); PG8_STAGE(PG8_SB(0, 0), b2, voffB);
            PG8_BAR; PG8_WAIT_L(0); PG8_MMA(0, 1, At, B1); PG8_BAR;
            PG8_LDA(At, 0, 1); PG8_STAGE(PG8_SA(0, 0), a2, voffA);
            PG8_BAR; PG8_WAIT_L(0); PG8_MMA(1, 0, At, B0); PG8_BAR; PG8_SCHED;
            PG8_STAGE(PG8_SB(0, 1), b2 + hstep, voffB);
            PG8_WAIT_V(6); PG8_BAR; PG8_MMA(1, 1, At, B1); PG8_BAR;
            PG8_LDB(B0, 1, 0); PG8_SCHED; PG8_LDA(At, 1, 0); PG8_STAGE(PG8_SA(0, 1), a2 + hstep, voffA);
            PG8_WAIT_L(8); PG8_BAR; PG8_WAIT_L(0); PG8_MMA(0, 0, At, B0); PG8_BAR; PG8_SCHED;
            PG8_LDB(B1, 1, 1); PG8_STAGE(PG8_SB(1, 0), b3, voffB);
            PG8_BAR; PG8_WAIT_L(0); PG8_MMA(0, 1, At, B1); PG8_BAR;
            PG8_LDA(At, 1, 1); PG8_STAGE(PG8_SA(1, 0), a3, voffA);
            PG8_BAR; PG8_WAIT_L(0); PG8_MMA(1, 0, At, B0); PG8_BAR; PG8_SCHED;
            PG8_STAGE(PG8_SB(1, 1), b3 + hstep, voffB);
            PG8_WAIT_V(6); PG8_BAR; PG8_MMA(1, 1, At, B1); PG8_BAR;
            }
        }
        if constexpr (ALIGN_EPI) { if (wr == 0) PG8_BAR; }
        if constexpr (!Epi::AFTER_DRAIN) { E(acc, cur, wr, wc, fr, fq); S.done(cur); }
        if (!has_next) break;
#pragma unroll
        for (int a = 0; a < 2; ++a)
#pragma unroll
            for (int b = 0; b < 2; ++b)
#pragma unroll
                for (int m = 0; m < 4; ++m)
#pragma unroll
                    for (int n = 0; n < 2; ++n) acc[a][b][m][n] = (f32x4){0.f, 0.f, 0.f, 0.f};
        cur = nxt; cA = nA; cB = nB; ++ui;
        if constexpr (ALIGN_EPI) { if (wr == 1) PG8_BAR; }
    }
    PG8_WAIT_V(0);
    if constexpr (!ALIGN_EPI) { if (wr == 0) PG8_BAR; }
    PG8_BAR;
    if constexpr (Epi::AFTER_DRAIN) { E.fused(acc, cur, wr, wc, fr, fq, lds, wid, lane); S.done(cur); }
#undef PG8_SA
#undef PG8_SB
#undef PG8_STAGE
#undef PG8_LDA
#undef PG8_LDB
#undef PG8_MMA
#undef PG8_WAIT_V
#undef PG8_WAIT_L
#undef PG8_BAR
#undef PG8_SCHED
}
}

#ifndef REP_ATT
#define REP_ATT 1
#endif
#ifndef REP_GEMM
#define REP_GEMM 1
#endif
#ifndef REP_ROW
#define REP_ROW 1
#endif
#ifndef REP_SYNC
#define REP_SYNC 0
#endif
#ifndef REP_P0
#define REP_P0 1
#endif
constexpr int DM = 1024, NB = 8, SEQ = 2048, DB = 16, DSEQ = 64, PAST = 2048;
constexpr int MP = NB * SEQ, MS = DB * DSEQ, MT = MP + MS;
constexpr int NIN = 3072, DFF = 4096, NMOD = 6 * DM;
constexpr float EPS = 1e-6f;
constexpr float LOG2E = 1.4426950408889634f;
constexpr size_t O_KVP = (size_t)MT * DM;
constexpr size_t KVP_SZ = (size_t)MP * 512;
constexpr size_t O_KVS = O_KVP + 4 * KVP_SZ;
constexpr size_t KVS_SZ = (size_t)MS * 512;
constexpr size_t MiB = 1u << 20;
constexpr size_t WS_CTL = 0, WS_MOD = 1 * MiB, WS_WIN = 2 * MiB, WS_WOUT = 8 * MiB, WS_WUP = 10 * MiB, WS_WDN = 18 * MiB;
constexpr size_t WS_XN = 26 * MiB, WS_U = 60 * MiB, WS_MIX = 162 * MiB, WS_HB = 60 * MiB, WS_Y = 196 * MiB, WS_END = 264 * MiB;
static_assert(WS_XN + (size_t)MT * DM * 2 <= WS_U && WS_U + (size_t)MT * NIN * 2 <= WS_MIX && WS_MIX + (size_t)MT * DM * 2 <= WS_Y && WS_HB + (size_t)MT * DFF * 2 <= WS_Y && WS_Y + (size_t)MT * DM * 4 <= WS_END, "ws map");
constexpr size_t WS_YP = 264 * MiB, WS_END2 = 328 * MiB;
constexpr int NSPLIT_O = 8, NSPLIT_D = 16;
constexpr int LDS_BYTES = 131072 + 1024;
constexpr int LDS_MISC = 131072;
constexpr int CW_BAR = 4096;
constexpr size_t CTL_ZERO_BYTES = 65536;

#define LAS __attribute__((address_space(3)))
#define DI __device__ __forceinline__
typedef unsigned short bf16_t;
typedef short bf16x8 __attribute__((ext_vector_type(8)));
typedef short s16x4 __attribute__((ext_vector_type(4)));
typedef float f32x4 __attribute__((ext_vector_type(4)));
typedef float f32x16 __attribute__((ext_vector_type(16)));
typedef unsigned u32x4 __attribute__((ext_vector_type(4)));
typedef unsigned u32x2 __attribute__((ext_vector_type(2)));
typedef float f32x2_t __attribute__((ext_vector_type(2)));
typedef __bf16 bf16x2_t __attribute__((ext_vector_type(2)));
DI unsigned cvtpk(float lo, float hi) { f32x2_t v = {lo, hi}; bf16x2_t b = __builtin_convertvector(v, bf16x2_t); return __builtin_bit_cast(unsigned, b); }
#define LDS_WAIT() asm volatile("s_waitcnt lgkmcnt(0)" ::: "memory")

namespace pg8 {
struct EpiQKV {
    static constexpr bool PERM = true, AFTER_DRAIN = false;
    bf16_t* U; float* out;
    __device__ __forceinline__ void operator()(const f32x4 (&acc)[2][2][4][2], const Unit& u, int wr, int wc, int fr, int fq) const {
        const int sec = u.pn >> 1;
        const bool kv = (sec == 1) || (sec == 2) || (sec == 4) || (sec == 5);
        const int kvi = (sec == 1) ? 0 : (sec == 2) ? 1 : (sec == 4) ? 2 : 3;
        const bool prompt = u.pm < (MP / BM);
        const float qs = (sec == 0 || sec == 3) ? 0.125f * LOG2E : 1.f;
        float* fbase = prompt ? out + O_KVP + (size_t)kvi * KVP_SZ : out + O_KVS + (size_t)kvi * KVS_SZ - (size_t)MP * 512;
        const int row0 = u.pm * BM + wr * 64 + fr, col0 = u.pn * BM + wc * 32 + 8 * fq, colsec = col0 - sec * 512;
#pragma unroll
        for (int ai = 0; ai < 2; ++ai)
#pragma unroll
            for (int m = 0; m < 4; ++m) { const int row = row0 + ai * HALF + m * 16;
#pragma unroll
                for (int bj = 0; bj < 2; ++bj) { const f32x4 v0 = acc[ai][bj][m][0], v1 = acc[ai][bj][m][1];
                    const f32x4 s0 = v0 * qs, s1 = v1 * qs;
                    u32x4 w; w.x = cvt_pk_bf16(s0[0], s0[1]); w.y = cvt_pk_bf16(s0[2], s0[3]); w.z = cvt_pk_bf16(s1[0], s1[1]); w.w = cvt_pk_bf16(s1[2], s1[3]);
                    *(u32x4*)(U + (size_t)row * NIN + col0 + bj * HALF) = w;
                    if (kv) { float* d = fbase + (size_t)row * 512 + colsec + bj * HALF; *(f32x4*)d = v0; *(f32x4*)(d + 4) = v1; } } }
    }
};
struct EpiF32 {
    static constexpr bool PERM = true, AFTER_DRAIN = false;
    float* Y; int ldc; float* Ypart;
    __device__ __forceinline__ void operator()(const f32x4 (&acc)[2][2][4][2], const Unit& u, int wr, int wc, int fr, int fq) const {
        const int row0 = u.pm * BM + wr * 64 + fr, col0 = u.pn * BM + wc * 32 + 8 * fq;
        float* base = (u.ks < 0) ? Y : Ypart + ((size_t)u.ks * MS - MP) * (size_t)ldc;
#pragma unroll
        for (int ai = 0; ai < 2; ++ai)
#pragma unroll
            for (int m = 0; m < 4; ++m) { float* rowp = base + (size_t)(row0 + ai * HALF + m * 16) * ldc + col0;
#pragma unroll
                for (int bj = 0; bj < 2; ++bj) { *(f32x4*)(rowp + bj * HALF) = acc[ai][bj][m][0]; *(f32x4*)(rowp + bj * HALF + 4) = acc[ai][bj][m][1]; } }
    }
};
struct EpiRelu2 {
    static constexpr bool PERM = true, AFTER_DRAIN = false;
    bf16_t* O; int ldc;
    __device__ __forceinline__ void operator()(const f32x4 (&acc)[2][2][4][2], const Unit& u, int wr, int wc, int fr, int fq) const {
        const int row0 = u.pm * BM + wr * 64 + fr, col0 = u.pn * BM + wc * 32 + 8 * fq;
#pragma unroll
        for (int ai = 0; ai < 2; ++ai)
#pragma unroll
            for (int m = 0; m < 4; ++m) { bf16_t* rowp = O + (size_t)(row0 + ai * HALF + m * 16) * ldc + col0;
#pragma unroll
                for (int bj = 0; bj < 2; ++bj) { f32x4 v0 = acc[ai][bj][m][0], v1 = acc[ai][bj][m][1];
                    v0 = __builtin_elementwise_max(v0, (f32x4){0.f, 0.f, 0.f, 0.f}); v1 = __builtin_elementwise_max(v1, (f32x4){0.f, 0.f, 0.f, 0.f}); v0 = v0 * v0; v1 = v1 * v1;
                    u32x4 w; w.x = cvt_pk_bf16(v0[0], v0[1]); w.y = cvt_pk_bf16(v0[2], v0[3]); w.z = cvt_pk_bf16(v1[0], v1[1]); w.w = cvt_pk_bf16(v1[2], v1[3]);
                    *(u32x4*)(rowp + bj * HALF) = w; } }
    }
};
}

DI float wave_sum(float v) {
#pragma unroll
    for (int o = 1; o < 64; o <<= 1) v += __shfl_xor(v, o);
    return v;
}
DI unsigned f2bf(float f) { unsigned u = __builtin_bit_cast(unsigned, f); return (u + 0x7fffu + ((u >> 16) & 1u)) >> 16; }
DI unsigned pk2(float lo, float hi) { return f2bf(lo) | (f2bf(hi) << 16); }
DI float xswap_add(float v) { auto rr = __builtin_amdgcn_permlane32_swap(__float_as_uint(v), __float_as_uint(v), false, false); return __uint_as_float(rr[0]) + __uint_as_float(rr[1]); }
DI float xswap_max(float v) { auto rr = __builtin_amdgcn_permlane32_swap(__float_as_uint(v), __float_as_uint(v), false, false); return fmaxf(__uint_as_float(rr[0]), __uint_as_float(rr[1])); }

DI void p0_transpose_item(const float* W, int K, int N, bf16_t* WT, LAS float* scr, int item, int lane) {
    const int nblk = N / 32, kb = item / nblk, nb = item % nblk, k0 = 64 * kb, n0 = 32 * nb;
#pragma unroll 8
    for (int i = 0; i < 32; ++i) { const int kk = 2 * i + (lane >> 5); scr[kk * 33 + (lane & 31)] = W[(size_t)(k0 + kk) * N + n0 + (lane & 31)]; }
    LDS_WAIT();
    const int c = lane & 7;
#pragma unroll
    for (int j = 0; j < 4; ++j) { const int n = (lane >> 3) + 8 * j; const LAS float* s = scr + (8 * c) * 33 + n;
        u32x4 o; o.x = pk2(s[0 * 33], s[1 * 33]); o.y = pk2(s[2 * 33], s[3 * 33]); o.z = pk2(s[4 * 33], s[5 * 33]); o.w = pk2(s[6 * 33], s[7 * 33]);
        *(u32x4*)(WT + (size_t)(n0 + n) * K + k0 + 8 * c) = o; }
    LDS_WAIT();
}
DI void p0_modulate_block(const float* cp, const float* cs, const float* w_ada, const float* b_ada, float* mod, LAS unsigned char* lds, int item, int tid, int lane, int wave) {
    LAS float* scr = (LAS float*)(lds + wave * 16384);
    LAS float* red = (LAS float*)(lds + wave * 16384 + 12288);
    for (int e = lane; e < 24 * 128; e += 64) { const int bi = e >> 7, j = e & 127;
        const float v = (bi < 8) ? cp[bi * DM + 128 * wave + j] : cs[(bi - 8) * DM + 128 * wave + j];
        scr[e] = v / (1.f + __expf(-v)); }
    LDS_WAIT();
    const int kh = lane >> 5;
    const float* wp = w_ada + (size_t)(128 * wave + 64 * kh) * NMOD + item * 32 + (lane & 31);
    float acc[24];
#pragma unroll
    for (int bi = 0; bi < 24; ++bi) acc[bi] = 0.f;
#pragma unroll 4
    for (int j4 = 0; j4 < 16; ++j4) {
        float wv[4];
#pragma unroll
        for (int q = 0; q < 4; ++q) wv[q] = wp[(size_t)(4 * j4 + q) * NMOD];
#pragma unroll
        for (int bi = 0; bi < 24; ++bi) { const f32x4 sv = *(const LAS f32x4*)(scr + bi * 128 + 64 * kh + 4 * j4); acc[bi] += (sv.x * wv[0] + sv.y * wv[1]) + (sv.z * wv[2] + sv.w * wv[3]); }
    }
#pragma unroll
    for (int bi = 0; bi < 24; ++bi) acc[bi] += __shfl_xor(acc[bi], 32);
    if (lane < 32) {
#pragma unroll
        for (int bi = 0; bi < 24; ++bi) red[bi * 32 + lane] = acc[bi]; }
    __syncthreads();
    for (int e = tid; e < 24 * 32; e += 512) { float sum = 0.f;
#pragma unroll
        for (int w8 = 0; w8 < 8; ++w8) sum += ((const LAS float*)(lds + w8 * 16384 + 12288))[e];
        const int c = item * 32 + (e & 31); mod[(e >> 5) * NMOD + c] = sum + b_ada[c]; }
    __syncthreads();
}

DI int row_bi(int row) { return row < MP ? (row >> 11) : 8 + ((row - MP) >> 6); }
DI void p1_row(const float* xrow, const float* mod, const float* g, bf16_t* orow, int bi, int lane) {
    const f32x4* xr = (const f32x4*)xrow + lane; f32x4 v[4]; float s = 0.f;
#pragma unroll
    for (int j = 0; j < 4; ++j) { v[j] = xr[64 * j]; s += (v[j].x * v[j].x + v[j].y * v[j].y) + (v[j].z * v[j].z + v[j].w * v[j].w); }
    const float r = rsqrtf(wave_sum(s) * (1.f / DM) + EPS);
    const f32x4* gg = (const f32x4*)g + lane; const f32x4* sh = (const f32x4*)(mod + (size_t)bi * NMOD) + lane; const f32x4* sc = (const f32x4*)(mod + (size_t)bi * NMOD + DM) + lane;
    u32x2* o8 = (u32x2*)orow + lane;
#pragma unroll
    for (int j = 0; j < 4; ++j) { const f32x4 h = v[j] * r * gg[64 * j] * (sc[64 * j] + 1.f) + sh[64 * j]; u32x2 w; w.x = cvtpk(h.x, h.y); w.y = cvtpk(h.z, h.w); o8[64 * j] = w; }
}
DI void p5_row(const float* xrow, const float* yrow, int nsum, const float* mod, const float* gpost, const float* gpre2, float* outrow, bf16_t* xnrow, int bi, int lane) {
    const f32x4* xr = (const f32x4*)xrow + lane; const f32x4* yr = (const f32x4*)yrow + lane; f32x4 y[4], x1[4]; float s = 0.f;
#pragma unroll
    for (int j = 0; j < 4; ++j) { y[j] = yr[64 * j]; for (int k = 1; k < nsum; ++k) y[j] = y[j] + yr[64 * j + (size_t)k * (MS * DM / 4)];
        s += (y[j].x * y[j].x + y[j].y * y[j].y) + (y[j].z * y[j].z + y[j].w * y[j].w); }
    const float r1 = rsqrtf(wave_sum(s) * (1.f / DM) + EPS);
    const float* mb = mod + (size_t)bi * NMOD;
    const f32x4* gp = (const f32x4*)gpost + lane; const f32x4* ga = (const f32x4*)(mb + 2 * DM) + lane;
    float s2 = 0.f; f32x4* orow = (f32x4*)outrow + lane;
#pragma unroll
    for (int j = 0; j < 4; ++j) { x1[j] = xr[64 * j] + ga[64 * j] * (y[j] * r1 * gp[64 * j]); orow[64 * j] = x1[j];
        s2 += (x1[j].x * x1[j].x + x1[j].y * x1[j].y) + (x1[j].z * x1[j].z + x1[j].w * x1[j].w); }
    const float r2 = rsqrtf(wave_sum(s2) * (1.f / DM) + EPS);
    const f32x4* g2 = (const f32x4*)gpre2 + lane; const f32x4* sh = (const f32x4*)(mb + 3 * DM) + lane; const f32x4* sc = (const f32x4*)(mb + 4 * DM) + lane;
    u32x2* o8 = (u32x2*)xnrow + lane;
#pragma unroll
    for (int j = 0; j < 4; ++j) { const f32x4 h = x1[j] * r2 * g2[64 * j] * (sc[64 * j] + 1.f) + sh[64 * j]; u32x2 w; w.x = cvtpk(h.x, h.y); w.y = cvtpk(h.z, h.w); o8[64 * j] = w; }
}
DI void p8_row(const float* yrow, int nsum, const float* mod, const float* gpost, float* outrow, int bi, int lane) {
    const f32x4* yr = (const f32x4*)yrow + lane; f32x4 y[4]; float s = 0.f;
#pragma unroll
    for (int j = 0; j < 4; ++j) { y[j] = yr[64 * j]; for (int k = 1; k < nsum; ++k) y[j] = y[j] + yr[64 * j + (size_t)k * (MS * DM / 4)];
        s += (y[j].x * y[j].x + y[j].y * y[j].y) + (y[j].z * y[j].z + y[j].w * y[j].w); }
    const float r1 = rsqrtf(wave_sum(s) * (1.f / DM) + EPS);
    const f32x4* gp = (const f32x4*)gpost + lane; const f32x4* ga = (const f32x4*)(mod + (size_t)bi * NMOD + 5 * DM) + lane; f32x4* orow = (f32x4*)outrow + lane;
#pragma unroll
    for (int j = 0; j < 4; ++j) orow[64 * j] = orow[64 * j] + ga[64 * j] * (y[j] * r1 * gp[64 * j]);
}

namespace att {
#define MFMA32(a, b, c) __builtin_amdgcn_mfma_f32_32x32x16_bf16((a), (b), (c), 0, 0, 0)
typedef short v4i16_t __attribute__((ext_vector_type(4)));
DI unsigned off_b(unsigned row, unsigned ch) { return 256u * row + 16u * (ch ^ (((row & 3u) << 2) | ((row >> 2) & 3u))); }
DI s16x4 trr(const LAS char* p) { return __builtin_bit_cast(s16x4, __builtin_amdgcn_ds_read_tr16_b64_v4i16((LAS v4i16_t*)p)); }
DI bf16x8 cat8(s16x4 lo, s16x4 hi) { return (bf16x8){lo[0], lo[1], lo[2], lo[3], hi[0], hi[1], hi[2], hi[3]}; }
template <int S> DI bf16x8 pack8(const f32x16& x) { u32x4 p; p[0] = cvtpk(x[8 * S], x[8 * S + 1]); p[1] = cvtpk(x[8 * S + 2], x[8 * S + 3]); p[2] = cvtpk(x[8 * S + 4], x[8 * S + 5]); p[3] = cvtpk(x[8 * S + 6], x[8 * S + 7]); return __builtin_bit_cast(bf16x8, p); }
DI u32x4 cvt8(u32x4 a, u32x4 b) {
    u32x4 o; o.x = cvtpk(__uint_as_float(a.x), __uint_as_float(a.y)); o.y = cvtpk(__uint_as_float(a.z), __uint_as_float(a.w));
    o.z = cvtpk(__uint_as_float(b.x), __uint_as_float(b.y)); o.w = cvtpk(__uint_as_float(b.z), __uint_as_float(b.w)); return o; }

struct Ctx {
    const bf16_t* U; bf16_t* MIX;
    const float *cdk, *cdv, *csk, *csv;
    const float* subg; float lam;
};

DI void diff_unit(const Ctx& C, LAS char* lds, bool sample, int b, int hh, int u) {
    int tid_ = threadIdx.x; asm volatile("" : "+v"(tid_));
    const int tid = tid_, lane = tid & 63, r = lane & 31, h = lane >> 5, w = __builtin_amdgcn_readfirstlane(tid >> 6);
    const int qblk = w >> 1, map = w & 1;
    const bool active = sample ? (w < 4) : true;
    const int ncache = sample ? 32 : 0;
    const int tokbase = sample ? MP + b * DSEQ : b * SEQ;
    const int cbase = b * PAST;
    const int Tmax = sample ? 32 : 2 * u + 1;
    const int qrel = sample ? 32 * qblk : 128 * u + 32 * qblk;
    const int Tw = sample ? 32 : (qrel >> 6);
    const int qpos = (sample ? PAST : 0) + qrel + r;
    const int qrow = tokbase + (active ? qrel : 0) + r;
    bf16x8 qf[4];
#pragma unroll
    for (int ds = 0; ds < 4; ++ds) qf[ds] = *(const bf16x8*)(C.U + (size_t)qrow * NIN + hh * 128 + map * 64 + 16 * ds + 8 * h);
    unsigned kaddr[4];
    { const unsigned x = ((r & 3u) << 2) | ((r >> 2) & 3u);
#pragma unroll
      for (int ds = 0; ds < 4; ++ds) kaddr[ds] = 256u * r + 16u * ((unsigned)(2 * (4 * map + ds) + h) ^ x); }
    unsigned vaddr[2][4];
    { const unsigned blk = (lane >> 4) & 1, q = (lane & 15) >> 2, p = lane & 3;
#pragma unroll
      for (int t = 0; t < 2; ++t)
#pragma unroll
          for (int c = 0; c < 4; ++c) vaddr[t][c] = off_b(8 * t + 4 * h + q, 4 * c + 2 * blk + (p >> 1)) + 8 * (p & 1); }
    const int srow = tid >> 4, sch = tid & 15;
    const unsigned sdst0 = off_b(srow, sch), sdst1 = off_b(srow + 32, sch);
    u32x4 st[4];
    auto issue_bf = [&](int t) {
        const bf16_t* g0 = C.U + (size_t)(tokbase + 64 * (t - ncache) + srow) * NIN + hh * 128 + sch * 8 + 512; const bf16_t* g1 = g0 + (size_t)32 * NIN;
        st[0] = *(const u32x4*)g0; st[1] = *(const u32x4*)g1; st[2] = *(const u32x4*)(g0 + 512); st[3] = *(const u32x4*)(g1 + 512);
    };
    auto commit_bf = [&](int buf) {
        LAS char* kimg = lds + buf * 32768; LAS char* vimg = kimg + 16384;
        *(LAS u32x4*)(kimg + sdst0) = st[0]; *(LAS u32x4*)(kimg + sdst1) = st[1]; *(LAS u32x4*)(vimg + sdst0) = st[2]; *(LAS u32x4*)(vimg + sdst1) = st[3];
    };
    auto issue_f32 = [&](int t, int isv) {
        const float* src = isv ? C.cdv : C.cdk;
        const size_t o0 = (size_t)(cbase + 64 * t + srow) * 512 + hh * 128 + sch * 8, o1 = o0 + (size_t)32 * 512;
        st[0] = *(const u32x4*)(src + o0); st[1] = *(const u32x4*)(src + o0 + 4); st[2] = *(const u32x4*)(src + o1); st[3] = *(const u32x4*)(src + o1 + 4);
    };
    auto commit_f32 = [&](int buf, int isv) {
        LAS char* img = lds + buf * 32768 + (isv ? 16384 : 0);
        *(LAS u32x4*)(img + sdst0) = cvt8(st[0], st[1]); *(LAS u32x4*)(img + sdst1) = cvt8(st[2], st[3]);
    };
    const float slope = __builtin_amdgcn_exp2f(-2.f * (float)(hh + 1));
    const float sl2 = slope * LOG2E;
    f32x16 o[4];
#pragma unroll
    for (int dt = 0; dt < 4; ++dt)
#pragma unroll
        for (int i = 0; i < 16; ++i) o[dt][i] = 0.f;
    float mrun = 0.f, lrun = 0.f;

    if (Tmax < ncache) { issue_f32(Tmax, 0); commit_f32(0, 0); issue_f32(Tmax, 1); commit_f32(0, 1); } else { issue_bf(Tmax); commit_bf(0); }
    __syncthreads();
    int cur = 0;
    for (int t = Tmax; t >= 0; --t) {
        const bool comp = active && t <= Tw;
        const bool nf32 = (t - 1) < ncache;
        const LAS char* kimg = lds + cur * 32768; const LAS char* vimg = kimg + 16384;
        bf16x8 P[4];
        if (t > 0) { if (nf32) issue_f32(t - 1, 0); else issue_bf(t - 1); }
        if (comp) {
            const bool diag = (t == Tw);
            f32x16 s0, s1;
            const float kb0 = sl2 * (float)(64 * t + 4 * h) - mrun;
            if (!diag) {
#pragma unroll
                for (int i = 0; i < 16; ++i) { const float ci = (float)((i & 3) + 8 * (i >> 2)); s0[i] = __builtin_fmaf(sl2, ci, kb0); s1[i] = __builtin_fmaf(sl2, ci + 32.f, kb0); }
            } else {
                float dq = (float)(qpos - 64 * t - 4 * h); asm volatile("" : "+v"(dq));
                const float m2 = -2.f * sl2;
#pragma unroll
                for (int i = 0; i < 16; ++i) { const float ci = (float)((i & 3) + 8 * (i >> 2));
                    s0[i] = __builtin_fmaf(m2, fmaxf(ci - dq, 0.f), __builtin_fmaf(sl2, ci, kb0)); s1[i] = __builtin_fmaf(m2, fmaxf(ci + 32.f - dq, 0.f), __builtin_fmaf(sl2, ci + 32.f, kb0)); }
            }
#pragma unroll
            for (int ds = 0; ds < 4; ++ds) {
                const bf16x8 k0 = *(const LAS bf16x8*)(kimg + kaddr[ds]); const bf16x8 k1 = *(const LAS bf16x8*)(kimg + kaddr[ds] + 8192);
                s0 = MFMA32(k0, qf[ds], s0); s1 = MFMA32(k1, qf[ds], s1); }
            float mx = fmaxf(s0[0], s1[0]);
#pragma unroll
            for (int i = 1; i < 16; ++i) mx = fmaxf(mx, fmaxf(s0[i], s1[i]));
            mx = xswap_max(mx);
            if (diag || __any(mx > 0.f)) {
                const float dl = diag ? mx : fmaxf(mx, 0.f), alpha = diag ? 0.f : __builtin_amdgcn_exp2f(-dl); mrun += dl; lrun *= alpha;
#pragma unroll
                for (int i = 0; i < 16; ++i) { s0[i] -= dl; s1[i] -= dl; }
#pragma unroll
                for (int dt = 0; dt < 4; ++dt)
#pragma unroll
                    for (int i = 0; i < 16; ++i) o[dt][i] *= alpha; }
            float ps = 0.f;
#pragma unroll
            for (int i = 0; i < 16; ++i) { s0[i] = __builtin_amdgcn_exp2f(s0[i]); s1[i] = __builtin_amdgcn_exp2f(s1[i]); ps += s0[i] + s1[i]; }
            lrun += ps;
            P[0] = pack8<0>(s0); P[1] = pack8<1>(s0); P[2] = pack8<0>(s1); P[3] = pack8<1>(s1);
        }
        if (t > 0 && nf32) { commit_f32(cur ^ 1, 0); issue_f32(t - 1, 1); }
        if (comp) {
#pragma unroll
            for (int dt = 0; dt < 4; ++dt)
#pragma unroll
                for (int ks = 0; ks < 4; ++ks) { const s16x4 lo = trr(vimg + vaddr[0][dt] + 4096 * ks), hi = trr(vimg + vaddr[1][dt] + 4096 * ks);
                    o[dt] = MFMA32(cat8(lo, hi), P[ks], o[dt]); }
        }
        if (t > 0) { if (nf32) commit_f32(cur ^ 1, 1); else commit_bf(cur ^ 1); }
        __syncthreads();
        cur ^= 1;
    }
    const float inv = 1.f / xswap_add(lrun);
    LAS float* X = (LAS float*)(lds + (w >> 1) * 16384);
    if (active && map == 1) { const float f = C.lam * inv;
#pragma unroll
        for (int dt = 0; dt < 4; ++dt)
#pragma unroll
            for (int i = 0; i < 16; ++i) X[(dt * 16 + i) * 64 + lane] = o[dt][i] * f; }
    __syncthreads();
    if (active && map == 0) { float ss = 0.f;
#pragma unroll
        for (int dt = 0; dt < 4; ++dt)
#pragma unroll
            for (int i = 0; i < 16; ++i) { const float v = o[dt][i] * inv - X[(dt * 16 + i) * 64 + lane]; o[dt][i] = v; ss += v * v; }
        ss = xswap_add(ss);
        const float rn = rsqrtf(ss * (1.f / 128.f) + EPS) * 0.8f;
        bf16_t* orow = C.MIX + (size_t)qrow * DM + hh * 128;
#pragma unroll
        for (int dt = 0; dt < 4; ++dt)
#pragma unroll
            for (int g = 0; g < 4; ++g) { const int d = 32 * dt + 8 * g + 4 * h; const f32x4 gg = *(const f32x4*)(C.subg + d);
                u32x2 wv; wv.x = cvtpk(o[dt][4 * g] * rn * gg.x, o[dt][4 * g + 1] * rn * gg.y); wv.y = cvtpk(o[dt][4 * g + 2] * rn * gg.z, o[dt][4 * g + 3] * rn * gg.w);
                *(u32x2*)(orow + d) = wv; } }
    __syncthreads();
}

constexpr float SB_THR = -150.f;
DI void sb_unit(const Ctx& C, LAS char* lds, bool sample, int b, int hh, int qb) {
    int tid_ = threadIdx.x; asm volatile("" : "+v"(tid_));
    const int tid = tid_, lane = tid & 63, r = lane & 31, h = lane >> 5, w = __builtin_amdgcn_readfirstlane(tid >> 6);
    const bool active = sample ? (w < 2) : true;
    const int ncache = sample ? 32 : 0;
    const int tokbase = sample ? MP + b * DSEQ : b * SEQ;
    const int cbase = b * PAST;
    const int Tmax = sample ? 32 : 4 * qb + 3;
    const int qrel = sample ? 32 * w : 256 * qb + 32 * w;
    const int Tw = sample ? 32 : (qrel >> 6);
    const int qi = (qrel & 63) + r;
    const int qrow = tokbase + (active ? qrel : 0) + r;
    LAS unsigned* flags = (LAS unsigned*)(lds + 32768);
    bf16x8 qf[4];
#pragma unroll
    for (int ds = 0; ds < 4; ++ds) qf[ds] = *(const bf16x8*)(C.U + (size_t)qrow * NIN + 1536 + hh * 64 + 16 * ds + 8 * h);
    unsigned kaddr[4];
    { const unsigned x = ((r & 3u) << 2) | ((r >> 2) & 3u);
#pragma unroll
      for (int ds = 0; ds < 4; ++ds) kaddr[ds] = 256u * r + 16u * ((unsigned)(2 * ds + h) ^ x); }
    unsigned vaddr[2][2];
    { const unsigned blk = (lane >> 4) & 1, q = (lane & 15) >> 2, p = lane & 3;
#pragma unroll
      for (int t = 0; t < 2; ++t)
#pragma unroll
          for (int c = 0; c < 2; ++c) vaddr[t][c] = off_b(8 * t + 4 * h + q, 4 * (c + 2) + 2 * blk + (p >> 1)) + 8 * (p & 1); }
    bf16x8 tri[2];
#pragma unroll
    for (int s = 0; s < 2; ++s)
#pragma unroll
        for (int j = 0; j < 8; ++j) tri[s][j] = ((16 * s + 8 * (j >> 2) + 4 * h + (j & 3)) > r) ? (short)0x3F80 : (short)0;
    const int srow = tid >> 4, sch = tid & 15;
    const unsigned sdst0 = off_b(srow, sch), sdst1 = off_b(srow + 32, sch);
    const int scol = (sch < 8) ? (2048 + hh * 64 + sch * 8) : (2560 + hh * 64 + (sch - 8) * 8);
    const float* csrc = (sch < 8) ? C.csk : C.csv;
    u32x4 st[4];
    auto issue = [&](int t) {
        if (t < ncache) {
            const size_t o0 = (size_t)(cbase + 64 * t + srow) * 512 + hh * 64 + (sch & 7) * 8, o1 = o0 + (size_t)32 * 512;
            st[0] = *(const u32x4*)(csrc + o0); st[1] = *(const u32x4*)(csrc + o0 + 4); st[2] = *(const u32x4*)(csrc + o1); st[3] = *(const u32x4*)(csrc + o1 + 4);
        } else {
            const bf16_t* g0 = C.U + (size_t)(tokbase + 64 * (t - ncache) + srow) * NIN + scol;
            st[0] = *(const u32x4*)g0; st[1] = *(const u32x4*)(g0 + (size_t)32 * NIN);
        }
    };
    auto commit = [&](int t, int buf) {
        LAS char* img = lds + buf * 16384;
        if (t < ncache) { *(LAS u32x4*)(img + sdst0) = cvt8(st[0], st[1]); *(LAS u32x4*)(img + sdst1) = cvt8(st[2], st[3]); }
        else { *(LAS u32x4*)(img + sdst0) = st[0]; *(LAS u32x4*)(img + sdst1) = st[1]; }
    };
    f32x16 o[2];
#pragma unroll
    for (int dt = 0; dt < 2; ++dt)
#pragma unroll
        for (int i = 0; i < 16; ++i) o[dt][i] = 0.f;
    float R = 0.f;

    issue(Tmax); commit(Tmax, 0); __syncthreads();
    int cur = 0;
    for (int t = Tmax; t >= 0; --t) {
        if (t > 0) issue(t - 1);
        unsigned done = active ? 0u : 1u;
        if (active && t <= Tw) {
            const LAS char* img = lds + cur * 16384;
            const bool diag = (t == Tw);
            bf16x8 P[4];
            float carry = R;
            float tsum = 0.f;
#define SB_HALF(KT) { \
                f32x16 z; _Pragma("unroll") for (int i = 0; i < 16; ++i) z[i] = 0.f; \
                _Pragma("unroll") for (int ds = 0; ds < 4; ++ds) { const bf16x8 kf = *(const LAS bf16x8*)(img + kaddr[ds] + 8192 * (KT)); z = MFMA32(kf, qf[ds], z); } \
                f32x16 ln; float sm = 0.f; \
                if (!diag) { \
                    _Pragma("unroll") for (int i = 0; i < 16; ++i) { const float e = __builtin_amdgcn_exp2f(-fabsf(z[i])); \
                        const float sp = fmaxf(z[i], 0.f) + __builtin_amdgcn_logf(1.f + e); ln[i] = -sp; z[i] -= sp; sm -= sp; } \
                } else { \
                    _Pragma("unroll") for (int i = 0; i < 16; ++i) { const float e = __builtin_amdgcn_exp2f(-fabsf(z[i])); \
                        const float sp = fmaxf(z[i], 0.f) + __builtin_amdgcn_logf(1.f + e); \
                        const bool earlier = (32 * (KT) + (i & 3) + 8 * (i >> 2) + 4 * h) < qi; \
                        ln[i] = earlier ? -sp : 0.f; z[i] = earlier ? (z[i] - sp) : -1e30f; sm += ln[i]; } \
                } \
                sm = xswap_add(sm); \
                f32x16 bt; _Pragma("unroll") for (int i = 0; i < 16; ++i) bt[i] = carry; \
                bt = MFMA32(tri[0], pack8<0>(ln), bt); bt = MFMA32(tri[1], pack8<1>(ln), bt); \
                _Pragma("unroll") for (int i = 0; i < 16; ++i) z[i] = __builtin_amdgcn_exp2f(z[i] + bt[i]); \
                P[2 * (KT)] = pack8<0>(z); P[2 * (KT) + 1] = pack8<1>(z); \
                carry += sm; tsum += sm; }
            SB_HALF(1)
            SB_HALF(0)
#undef SB_HALF
            R += tsum;
#pragma unroll
            for (int dt = 0; dt < 2; ++dt)
#pragma unroll
                for (int ks = 0; ks < 4; ++ks) { const s16x4 lo = trr(img + vaddr[0][dt] + 4096 * ks), hi = trr(img + vaddr[1][dt] + 4096 * ks);
                    o[dt] = MFMA32(cat8(lo, hi), P[ks], o[dt]); }
            done = __all(R < SB_THR) ? 1u : 0u;
        }
        if (lane == 0) flags[(cur << 3) + w] = done;
        if (t > 0) commit(t - 1, cur ^ 1);
        __syncthreads();
        bool alld = true;
#pragma unroll
        for (int k = 0; k < 8; ++k) alld = alld && (flags[(cur << 3) + k] != 0u);
        cur ^= 1;
        if (alld) break;
    }
    if (active) {
        bf16_t* orow = C.MIX + (size_t)qrow * DM + 512 + hh * 64;
#pragma unroll
        for (int dt = 0; dt < 2; ++dt)
#pragma unroll
            for (int g = 0; g < 4; ++g) { const int d = 32 * dt + 8 * g + 4 * h;
                u32x2 wv; wv.x = cvtpk(o[dt][4 * g], o[dt][4 * g + 1]); wv.y = cvtpk(o[dt][4 * g + 2], o[dt][4 * g + 3]);
                *(u32x2*)(orow + d) = wv; }
    }
    __syncthreads();
}
constexpr int N_DS = 64, N_DP = 512, N_SP = 512, N_SS = 128, N_UNITS = N_DS + N_DP + N_SP + N_SS;
}

#define XB_TMO      128
#define XB_XCNT(j)  (256  + 64 * (j))
#define XB_XSUB(j)  (1280 + 64 * (j))
#define XB_XGEN(j)  (2304 + 64 * (j))
#define XB_TOP      3328
#define XB_TOPGEN   3392
#define XCD_BAR_WORDS 3456
#define XB_SPIN_CAP (1u << 18)

__device__ __forceinline__ unsigned xb_ld(unsigned* p)              { return __hip_atomic_load(p, __ATOMIC_RELAXED, __HIP_MEMORY_SCOPE_AGENT); }
__device__ __forceinline__ unsigned xb_add(unsigned* p, unsigned v) { return __hip_atomic_fetch_add(p, v, __ATOMIC_RELAXED, __HIP_MEMORY_SCOPE_AGENT); }
__device__ __forceinline__ unsigned xb_xcc_id() { return (unsigned)__builtin_amdgcn_s_getreg((3 << 11) | 20) & 0xFu; }
#define XB_SPIN(cond, bar) do { unsigned _sp = 0; while (cond) { __builtin_amdgcn_s_sleep(1); \
    if ((++_sp & 255u) == 0u) { if (xb_ld(&(bar)[XB_TMO])) break; if (_sp > XB_SPIN_CAP) { atomicAdd(&(bar)[XB_TMO], 1u); break; } } } } while (0)

struct XcdBarrier {
    unsigned* bar; unsigned x;
    volatile LAS unsigned* st;
};

__device__ __forceinline__ XcdBarrier xcd_barrier_post(unsigned* bar, volatile LAS unsigned* st) {
    XcdBarrier b; b.bar = bar; b.x = xb_xcc_id(); b.st = st;
    if (threadIdx.x == 0) (void)xb_add(&bar[XB_XCNT(b.x)], 1u);
    return b;
}
__device__ __forceinline__ void xcd_barrier_complete(unsigned* bar, unsigned x, unsigned& nloc, unsigned& nx) {
    const unsigned G = gridDim.x * gridDim.y * gridDim.z;
    unsigned sum, cnt, mine, sp = 0u;
    for (;;) {
        sum = 0u; cnt = 0u; mine = 0u;
#pragma unroll
        for (unsigned j = 0; j < 16; ++j) { const unsigned c = xb_ld(&bar[XB_XCNT(j)]); sum += c; cnt += (c > 0u) ? 1u : 0u; mine = (j == x) ? c : mine; }
        if (sum == G) break;
        __builtin_amdgcn_s_sleep(1);
        if ((++sp & 255u) == 0u) { if (xb_ld(&bar[XB_TMO])) break; if (sp > XB_SPIN_CAP) { atomicAdd(&bar[XB_TMO], 1u); break; } }
    }
    nloc = mine > 0u ? mine : 1u; nx = cnt > 0u ? cnt : 1u;
}

__device__ __forceinline__ void xcd_barrier(const XcdBarrier& b) {
    asm volatile("s_waitcnt vmcnt(0)" ::: "memory");
    __syncthreads();
    if (threadIdx.x == 0) {
        unsigned* bar = b.bar;
        __builtin_amdgcn_s_waitcnt(0);
        unsigned nloc = b.st[0], nx = b.st[1];
        if (nloc == 0u) { xcd_barrier_complete(bar, b.x, nloc, nx); b.st[0] = nloc; b.st[1] = nx; }
        const unsigned old = xb_add(&bar[XB_XSUB(b.x)], 1u);
        const unsigned gen = old / nloc;
        if (old + 1u == (gen + 1u) * nloc) {
            __builtin_amdgcn_fence(__ATOMIC_RELEASE, "agent");
            asm volatile("s_waitcnt vmcnt(0)" ::: "memory");
            const unsigned og = xb_add(&bar[XB_TOP], 1u);
            const unsigned tg = og / nx;
            if (og + 1u == (tg + 1u) * nx) xb_add(&bar[XB_TOPGEN], 1u);
            else XB_SPIN(xb_ld(&bar[XB_TOPGEN]) == tg, bar);
            __builtin_amdgcn_fence(__ATOMIC_ACQUIRE, "agent");
            xb_add(&bar[XB_XGEN(b.x)], 1u);
            asm volatile("s_waitcnt vmcnt(0)" ::: "memory");
        } else {
            XB_SPIN(xb_ld(&bar[XB_XGEN(b.x)]) == gen, bar);
            __builtin_amdgcn_fence(__ATOMIC_ACQUIRE, "agent");
            asm volatile("s_waitcnt vmcnt(0)" ::: "memory");
        }
    }
    __syncthreads();
}

struct Params { const float* in[23]; float* out; unsigned char* ws; };

__global__ void __launch_bounds__(512, 2) fwd_megakernel(Params p) {
    extern __shared__ __attribute__((aligned(16))) unsigned char lds_raw[];
    cg::grid_group grid = cg::this_grid();
    LAS unsigned char* lds = (LAS unsigned char*)lds_raw;
    const int tid = threadIdx.x, lane = tid & 63, wave = __builtin_amdgcn_readfirstlane(tid >> 6);
    const int G = gridDim.x, NGW = G * 8, gw = wave * G + (int)blockIdx.x;
    unsigned char* ws = p.ws;
    unsigned* ctl = (unsigned*)(ws + WS_CTL);
    float* mod = (float*)(ws + WS_MOD);
    bf16_t* Win_t = (bf16_t*)(ws + WS_WIN); bf16_t* Wout_t = (bf16_t*)(ws + WS_WOUT); bf16_t* Wup_t = (bf16_t*)(ws + WS_WUP); bf16_t* Wdn_t = (bf16_t*)(ws + WS_WDN);
    bf16_t* XN = (bf16_t*)(ws + WS_XN); bf16_t* U = (bf16_t*)(ws + WS_U); bf16_t* MIX = (bf16_t*)(ws + WS_MIX); bf16_t* HB = (bf16_t*)(ws + WS_HB);
    float* Y = (float*)(ws + WS_Y); float* YP = (float*)(ws + WS_YP);
    const float* xp = p.in[0]; const float* xs = p.in[1];
    volatile LAS unsigned* bst = (volatile LAS unsigned*)(lds + LDS_MISC + 32);
    if (tid < 2) bst[tid] = 0u;
    __syncthreads();
    XcdBarrier bar = xcd_barrier_post(ctl + CW_BAR, bst);

    {
        if (blockIdx.x == 0 && tid < 8) ctl[tid] = 0u;
        LAS float* scr = (LAS float*)(lds + wave * 16384);
        constexpr int I_MOD = NMOD / 32, I_IN = (DM / 64) * (NIN / 32), I_OUT = (DM / 64) * (DM / 32), I_UP = (DM / 64) * (DFF / 32), I_DN = (DFF / 64) * (DM / 32);
        constexpr int NITEMS = I_IN + I_OUT + I_UP + I_DN;
        for (int rep = 0; rep < REP_P0; ++rep) {
        for (int it = (int)blockIdx.x; it < I_MOD; it += G) p0_modulate_block(p.in[2], p.in[3], p.in[8], p.in[9], mod, lds, it, tid, lane, wave);
        for (int it = gw; it < NITEMS; it += NGW) {
            int r = it;
            if (r < I_IN) { p0_transpose_item(p.in[12], DM, NIN, Win_t, scr, r, lane); continue; } r -= I_IN;
            if (r < I_OUT) { p0_transpose_item(p.in[18], DM, DM, Wout_t, scr, r, lane); continue; } r -= I_OUT;
            if (r < I_UP) { p0_transpose_item(p.in[21], DM, DFF, Wup_t, scr, r, lane); continue; } r -= I_UP;
            p0_transpose_item(p.in[22], DFF, DM, Wdn_t, scr, r, lane);
        }
        }
    }
    if (p.ws == nullptr) grid.sync();
    xcd_barrier(bar);
    for (int rep = 0; rep < REP_SYNC; ++rep) xcd_barrier(bar);
    for (int rep = 0; rep < REP_ROW; ++rep)
    for (int row = gw; row < MT; row += NGW) {
        const float* xr = row < MP ? xp + (size_t)row * DM : xs + (size_t)(row - MP) * DM;
        p1_row(xr, mod, p.in[10], XN + (size_t)row * DM, row_bi(row), lane);
    }
    xcd_barrier(bar);
    {
        pg8::Gemm g{XN, Win_t, MT, NIN, DM}; pg8::StaticOrder S; S.init(MT, NIN, G, (int)blockIdx.x, DM);
        pg8::EpiQKV E{U, p.out};
        pg8::gemm_phase<pg8::EpiQKV, pg8::StaticOrder, true, true>(lds, g, S, E);
#if REP_GEMM > 1 || defined(REP_G1)
        __syncthreads(); pg8::gemm_phase<pg8::EpiQKV, pg8::StaticOrder, true, true>(lds, g, S, E);
#endif
    }
    xcd_barrier(bar);
#ifndef NO_ATT
    {
        att::Ctx C; C.U = U; C.MIX = MIX; C.cdk = p.in[4]; C.cdv = p.in[5]; C.csk = p.in[6]; C.csv = p.in[7]; C.subg = p.in[17];
        { const float a = p.in[13][lane] * p.in[14][lane], bq = p.in[15][lane] * p.in[16][lane];
          C.lam = __expf(wave_sum(a)) - __expf(wave_sum(bq)) + 0.2f; }
        LAS unsigned* qword = (LAS unsigned*)(lds + LDS_MISC);
        for (int rep = 0; rep < REP_ATT; ++rep)
        for (;;) {
            if (tid == 0) qword[0] = atomicAdd(ctl + rep, 1u);
            __syncthreads();
            const int idx = (int)qword[0];
            __syncthreads();
            if (idx >= att::N_UNITS) break;
            bool is_diff, sample; int ub, uh, uu;
            if (idx < att::N_DS) { is_diff = true; sample = true; ub = idx >> 2; uh = idx & 3; uu = 0; }
            else if (idx < att::N_DS + att::N_DP) { const int j = idx - att::N_DS; is_diff = true; sample = false; ub = (j & 31) >> 2; uh = j & 3; uu = 15 - (j >> 5); }
            else if (idx < att::N_DS + att::N_DP + att::N_SP) { const int j = idx - att::N_DS - att::N_DP; is_diff = false; sample = false; ub = (j & 63) >> 3; uh = j & 7; uu = 7 - (j >> 6); }
            else { const int j = idx - att::N_DS - att::N_DP - att::N_SP; is_diff = false; sample = true; ub = j >> 3; uh = j & 7; uu = 0; }
#ifdef ATT_MASK
            if (rep > 0) { const int cls = is_diff ? (sample ? 1 : 2) : (sample ? 8 : 4); if (!(cls & ATT_MASK)) continue; }
#endif
            if (is_diff) att::diff_unit(C, (LAS char*)lds, sample, ub, uh, uu);
            else att::sb_unit(C, (LAS char*)lds, sample, ub, uh, uu);
        }
    }
#endif
    xcd_barrier(bar);
    {
        pg8::Gemm g{MIX, Wout_t, MT, DM, DM}; pg8::SplitOrder S; S.init(MP, MT, DM, G, (int)blockIdx.x, DM, NSPLIT_O);
        pg8::EpiF32 E{Y, DM, YP};
        pg8::gemm_phase<pg8::EpiF32, pg8::SplitOrder, true, true>(lds, g, S, E);
#if REP_GEMM > 1 || defined(REP_G2)
        __syncthreads(); pg8::gemm_phase<pg8::EpiF32, pg8::SplitOrder, true, true>(lds, g, S, E);
#endif
    }
    xcd_barrier(bar);
    for (int rep = 0; rep < REP_ROW; ++rep)
    for (int row = gw; row < MT; row += NGW) {
        const float* xr = row < MP ? xp + (size_t)row * DM : xs + (size_t)(row - MP) * DM;
        p5_row(xr, row < MP ? Y + (size_t)row * DM : YP + (size_t)(row - MP) * DM, row < MP ? 1 : NSPLIT_O, mod, p.in[11], p.in[19], p.out + (size_t)row * DM, XN + (size_t)row * DM, row_bi(row), lane);
    }
    xcd_barrier(bar);
    {
        pg8::Gemm g{XN, Wup_t, MT, DFF, DM}; pg8::StaticOrder S; S.init(MT, DFF, G, (int)blockIdx.x, DM);
        pg8::EpiRelu2 E{HB, DFF};
        pg8::gemm_phase<pg8::EpiRelu2, pg8::StaticOrder, true, true>(lds, g, S, E);
#if REP_GEMM > 1 || defined(REP_G3)
        __syncthreads(); pg8::gemm_phase<pg8::EpiRelu2, pg8::StaticOrder, true, true>(lds, g, S, E);
#endif
    }
    xcd_barrier(bar);
    {
        pg8::Gemm g{HB, Wdn_t, MT, DM, DFF}; pg8::SplitOrder S; S.init(MP, MT, DM, G, (int)blockIdx.x, DFF, NSPLIT_D);
        pg8::EpiF32 E{Y, DM, YP};
        pg8::gemm_phase<pg8::EpiF32, pg8::SplitOrder, true, true>(lds, g, S, E);
#if REP_GEMM > 1 || defined(REP_G4)
        __syncthreads(); pg8::gemm_phase<pg8::EpiF32, pg8::SplitOrder, true, true>(lds, g, S, E);
#endif
    }
    xcd_barrier(bar);
    for (int row = gw; row < MT; row += NGW)
        p8_row(row < MP ? Y + (size_t)row * DM : YP + (size_t)(row - MP) * DM, row < MP ? 1 : NSPLIT_D, mod, p.in[20], p.out + (size_t)row * DM, row_bi(row), lane);
}

extern "C" void kernel_launch(void* const* d_in, const int* in_sizes, int n_in, void* d_out, int out_size, void* d_ws, size_t ws_size, hipStream_t stream) {
    static int grid_blocks = 0;
    if (grid_blocks == 0) {
        if (n_in != 23 || ws_size < WS_END2) { fprintf(stderr, "kernel_launch: unexpected n_in %d / ws_size %zu\n", n_in, ws_size); grid_blocks = -1; return; }
        int dev = 0, cus = 0, per_cu = 0;
        hipGetDevice(&dev);
        hipDeviceGetAttribute(&cus, hipDeviceAttributeMultiprocessorCount, dev);
        hipFuncSetAttribute((const void*)fwd_megakernel, hipFuncAttributeMaxDynamicSharedMemorySize, LDS_BYTES);
        hipOccupancyMaxActiveBlocksPerMultiprocessor(&per_cu, (const void*)fwd_megakernel, 512, LDS_BYTES);
        (void)hipGetLastError();
        if (per_cu < 1) per_cu = 1;
        grid_blocks = cus * 1;
    }
    if (grid_blocks < 0) return;
    if (hipMemsetAsync((char*)d_ws + WS_CTL, 0, CTL_ZERO_BYTES, stream) != hipSuccess) { fprintf(stderr, "kernel_launch: memset failed\n"); return; }
    Params p{};
    for (int i = 0; i < 23; ++i) p.in[i] = (const float*)d_in[i];
    p.out = (float*)d_out; p.ws = (unsigned char*)d_ws;
    void* args[] = {&p};
    hipError_t e = hipLaunchCooperativeKernel((const void*)fwd_megakernel, dim3(grid_blocks), dim3(512), args, LDS_BYTES, stream);
    if (e != hipSuccess) fprintf(stderr, "cooperative launch failed: %s (grid %d)\n", hipGetErrorString(e), grid_blocks);
}
```

```cpp
#include <hip/hip_runtime.h>
#include <hip/hip_cooperative_groups.h>
#include <cstdio>
#include <cstdint>
namespace cg = cooperative_groups;
namespace pg8 {
#define PG8_LAS __attribute__((address_space(3)))
typedef unsigned short bf16_t;
typedef short bf16x8 __attribute__((ext_vector_type(8)));
typedef float f32x4 __attribute__((ext_vector_type(4)));
typedef unsigned u32x4 __attribute__((ext_vector_type(4)));
constexpr int BM = 256, BK = 64, HALF = 128, HTB = HALF * BK * 2  , STAGE_BYTES = 8 * HTB, NXCD = 8, WGM = 8;

__host__ __device__ __forceinline__ int lds_byte(int r, int c) { const int st = (r >> 4) * 2 + (c >> 5), rr = r & 15, cc = c & 31, ob = rr * 64 + cc * 2; return st * 1024 + (ob ^ (((ob >> 9) & 1) << 5)); }
__host__ __device__ __forceinline__ void stage_rc(int b, int& R, int& C) { const int st = b / 1024, sb = b % 1024, swz = sb ^ (((sb >> 9) & 1) << 5); R = (st >> 1) * 16 + swz / 64; C = (st & 1) * 32 + (swz % 64) / 2; }
__host__ __device__ __forceinline__ int perm32(int rho) { const int n = rho >> 4, i = rho & 15; return 8 * (i >> 2) + 4 * n + (i & 3); }

struct Unit { int pm, pn, k0, kn, ks; };
struct Gemm { const bf16_t* A; const bf16_t* Bt; int M, N, K; };

struct StaticOrder {
    int nM, nN, nwg, G, c, kt;
    __host__ __device__ void init(int M, int N, int G_, int c_, int K_) { nM = M / BM; nN = N / BM; nwg = nM * nN; G = G_; c = c_; kt = K_ / BK; }
    __host__ __device__ bool next(int i, Unit& u) const {
        const long L = (long)i * G + c; if (L >= nwg) return false;
        int wgid = (int)L; { const int q = nwg / NXCD, r = nwg % NXCD, xcd = wgid % NXCD, off = wgid / NXCD; wgid = (xcd < r ? xcd * (q + 1) : r * (q + 1) + (xcd - r) * q) + off; }
        const int nig = WGM * nN, gid = wgid / nig, fm = gid * WGM, gsz = (nM - fm) < WGM ? (nM - fm) : WGM;
        u.pm = fm + ((wgid % nig) % gsz); u.pn = (wgid % nig) / gsz; u.k0 = 0; u.kn = kt; u.ks = -1; return true;
    }
    __device__ __forceinline__ void a_ready(const Unit&) const {}
    __device__ __forceinline__ void done(const Unit&) const {}
};

struct SplitOrder {
    StaticOrder so; int pm0, nN, nsplit, kext, npieces, G, c;
    __host__ __device__ void init(int M0, int M, int N, int G_, int c_, int K_, int nsplit_) { so.init(M0, N, G_, c_, K_); pm0 = M0 / BM; nN = N / BM; nsplit = nsplit_; kext = K_ / nsplit_; npieces = ((M - M0) / BM) * nN * nsplit_; G = G_; c = c_; }
    __host__ __device__ bool next(int i, Unit& u) const {
        if (so.next(i, u)) return true;
        const int nmine = (so.nwg > c) ? (so.nwg - c + G - 1) / G : 0;
        const long L = (long)(i - nmine) * G + c; if (L >= npieces) return false;
        const int tile = (int)L / nsplit, ks = (int)L % nsplit;
        u.pm = pm0 + tile / nN; u.pn = tile % nN; u.k0 = ks * kext; u.kn = kext / BK; u.ks = ks; return true;
    }
    __device__ __forceinline__ void a_ready(const Unit&) const {}
    __device__ __forceinline__ void done(const Unit&) const {}
};

__device__ __forceinline__ unsigned cvt_pk_bf16(float lo, float hi) { unsigned r; asm volatile("v_cvt_pk_bf16_f32 %0, %1, %2" : "=v"(r) : "v"(lo), "v"(hi)); return r; }
typedef float f32x2 __attribute__((ext_vector_type(2)));
__device__ __forceinline__ f32x2 gelu_pk(f32x2 v) {
    const f32x2 av = __builtin_elementwise_abs(v), d = av * 0.2316418882f + 1.0f;
    f32x2 t; t.x = __builtin_amdgcn_rcpf(d.x); t.y = __builtin_amdgcn_rcpf(d.y);
    f32x2 q = t * 0.5307027145f + (-0.7265760135f); q = q * t + 0.7107068705f; q = q * t + (-0.142248368f); q = q * t + 0.127414796f; q = q * t;
    const f32x2 s = (v * v) * (-0.72134752044f);
    f32x2 e; e.x = __builtin_amdgcn_exp2f(s.x); e.y = __builtin_amdgcn_exp2f(s.y);
    const f32x2 m = v * (q * e), r = v - m;
    f32x2 o; o.x = v.x < 0.f ? m.x : r.x; o.y = v.y < 0.f ? m.y : r.y; return o;
}

template <int ACT  > struct EpiBf16 {
    static constexpr bool PERM = true, AFTER_DRAIN = false; static_assert(ACT == 0 || ACT == 1, "EpiBf16: ACT is 0 (none) or 1 (gelu_pk)");
    bf16_t* O; int ldc; const float* bias; int split_cols; size_t split_stride; float scale0;
    __device__ __forceinline__ void operator()(const f32x4 (&acc)[2][2][4][2], const Unit& u, int wr, int wc, int fr, int fq) const {
        const int row0 = u.pm * BM + wr * 64 + fr; int colt = u.pn * BM; bf16_t* base = O;
        float sc = 1.f; if (split_cols) { const int t = colt / split_cols; base += (size_t)t * split_stride; colt -= t * split_cols; if (t == 0) sc = scale0; }
        const int col0 = colt + wc * 32 + 8 * fq, bcol0 = u.pn * BM + wc * 32 + 8 * fq;
        f32x4 bv[2][2];
#pragma unroll
        for (int bj = 0; bj < 2; ++bj)
#pragma unroll
            for (int n = 0; n < 2; ++n) bv[bj][n] = bias ? *(const f32x4*)(bias + bcol0 + bj * HALF + 4 * n) : (f32x4){0.f, 0.f, 0.f, 0.f};
#pragma unroll
        for (int ai = 0; ai < 2; ++ai)
#pragma unroll
            for (int m = 0; m < 4; ++m) { bf16_t* rowp = base + (size_t)(row0 + ai * HALF + m * 16) * ldc + col0;
#pragma unroll
                for (int bj = 0; bj < 2; ++bj) { f32x4 v0 = acc[ai][bj][m][0] + bv[bj][0], v1 = acc[ai][bj][m][1] + bv[bj][1];
                    if (ACT == 1) { f32x2 a = gelu_pk((f32x2){v0[0], v0[1]}), b = gelu_pk((f32x2){v0[2], v0[3]}), c = gelu_pk((f32x2){v1[0], v1[1]}), d = gelu_pk((f32x2){v1[2], v1[3]});
                        v0 = (f32x4){a.x, a.y, b.x, b.y}; v1 = (f32x4){c.x, c.y, d.x, d.y}; }
                    v0 = v0 * sc; v1 = v1 * sc; u32x4 w; w.x = cvt_pk_bf16(v0[0], v0[1]); w.y = cvt_pk_bf16(v0[2], v0[3]); w.z = cvt_pk_bf16(v1[0], v1[1]); w.w = cvt_pk_bf16(v1[2], v1[3]);
                    *(u32x4*)(rowp + bj * HALF) = w; } }
    }
};

template <class Epi, class Sched, bool ALIGN_EPI = false, bool SP2 = false>
__device__ __forceinline__ void gemm_phase(PG8_LAS unsigned char* lds, const Gemm g, const Sched& S, const Epi& E) {
    const int tid = threadIdx.x, wid = __builtin_amdgcn_readfirstlane(tid >> 6), lane = tid & 63, wr = wid >> 2, wc = wid & 3, fr = lane & 15, fq = lane >> 4;
    const int K = g.K;
    unsigned voffA[2], voffB[2];
#pragma unroll
    for (int i = 0; i < 2; ++i) { int R, C; stage_rc(tid * 16 + i * 8192, R, C); const int Rb = Epi::PERM ? ((R & ~31) + perm32(R & 31)) : R;
        voffA[i] = (unsigned)(R * K + C) * 2u; voffB[i] = (unsigned)(Rb * K + C) * 2u; }
    const size_t kstep = (size_t)(BK * 2);
    const size_t hstep = (size_t)HALF * K * 2;
    const size_t tstep = 2 * hstep;
    const unsigned ldsw = (unsigned)wid * 1024u;
    const int aoff = lds_byte(wr * 64 + fr, fq * 8), boff = lds_byte(wc * 32 + fr, fq * 8);
#define PG8_SA(b, h) (((b) * 2 + (h)) * HTB)
#define PG8_SB(b, h) ((4 + (b) * 2 + (h)) * HTB)
#define PG8_STAGE(bufoff, gbase, voff) do { _Pragma("unroll") for (int _i = 0; _i < 2; ++_i) \
        __builtin_amdgcn_global_load_lds((const unsigned*)((const char*)(gbase) + (voff)[_i]), (PG8_LAS unsigned*)(lds + (bufoff) + ldsw + _i * 8192), 16, 0, 0); } while (0)
#define PG8_LDA(dst, b, h) do { _Pragma("unroll") for (int m = 0; m < 4; ++m) _Pragma("unroll") for (int k = 0; k < 2; ++k) dst[m][k] = *(const PG8_LAS bf16x8*)(lds + PG8_SA(b, h) + aoff + m * 2048 + k * 1024); } while (0)
#define PG8_LDB(dst, b, h) do { _Pragma("unroll") for (int n = 0; n < 2; ++n) _Pragma("unroll") for (int k = 0; k < 2; ++k) dst[n][k] = *(const PG8_LAS bf16x8*)(lds + PG8_SB(b, h) + boff + n * 2048 + k * 1024); } while (0)
#define PG8_MMA(ai, bj, At, Bt) do { __builtin_amdgcn_s_setprio(1); _Pragma("unroll") for (int m = 0; m < 4; ++m) _Pragma("unroll") for (int n = 0; n < 2; ++n) _Pragma("unroll") for (int k = 0; k < 2; ++k) \
        acc[ai][bj][m][n] = __builtin_amdgcn_mfma_f32_16x16x32_bf16(Bt[n][k], At[m][k], acc[ai][bj][m][n], 0, 0, 0); __builtin_amdgcn_s_setprio(0); } while (0)
#define PG8_WAIT_V(n) asm volatile("s_waitcnt vmcnt(" #n ")" ::: "memory")
#define PG8_WAIT_L(n) asm volatile("s_waitcnt lgkmcnt(" #n ")" ::: "memory")
#define PG8_BAR __builtin_amdgcn_s_barrier()
#define PG8_SCHED __builtin_amdgcn_sched_barrier(0)
    Unit cur, nxt; int ui = 0;
    if (!S.next(0, cur)) return;
    f32x4 acc[2][2][4][2];
#pragma unroll
    for (int a = 0; a < 2; ++a)
#pragma unroll
        for (int b = 0; b < 2; ++b)
#pragma unroll
            for (int m = 0; m < 4; ++m)
#pragma unroll
                for (int n = 0; n < 2; ++n) acc[a][b][m][n] = (f32x4){0.f, 0.f, 0.f, 0.f};
    bf16x8 At[4][2], B0[2][2], B1[2][2];
    const char* cA = (const char*)g.A + (size_t)cur.pm * tstep + (size_t)cur.k0 * 2; const char* cB = (const char*)g.Bt + (size_t)cur.pn * tstep + (size_t)cur.k0 * 2;
    S.a_ready(cur);
    if constexpr (SP2) {
        PG8_STAGE(PG8_SB(0, 0), cB, voffB); PG8_STAGE(PG8_SB(0, 1), cB + hstep, voffB); PG8_STAGE(PG8_SA(0, 0), cA, voffA); PG8_STAGE(PG8_SA(0, 1), cA + hstep, voffA);
        if (wr == 1) PG8_BAR;
        PG8_WAIT_V(2); PG8_BAR;
        PG8_STAGE(PG8_SB(1, 0), cB + kstep, voffB); PG8_STAGE(PG8_SA(1, 0), cA + kstep, voffA); PG8_STAGE(PG8_SB(1, 1), cB + hstep + kstep, voffB);
        PG8_WAIT_V(6); PG8_BAR;
    } else {
        PG8_STAGE(PG8_SB(0, 0), cB, voffB); PG8_STAGE(PG8_SA(0, 0), cA, voffA); PG8_STAGE(PG8_SB(0, 1), cB + hstep, voffB); PG8_STAGE(PG8_SA(0, 1), cA + hstep, voffA);
        if (wr == 1) PG8_BAR;
        PG8_WAIT_V(4); PG8_BAR;
        PG8_STAGE(PG8_SB(1, 0), cB + kstep, voffB); PG8_STAGE(PG8_SA(1, 0), cA + kstep, voffA); PG8_STAGE(PG8_SB(1, 1), cB + hstep + kstep, voffB);
        PG8_WAIT_V(6); PG8_BAR;
    }
    for (;;) {
        const bool has_next = S.next(ui + 1, nxt);
        const char* nA = has_next ? (const char*)g.A + (size_t)nxt.pm * tstep + (size_t)nxt.k0 * 2 : cA; const char* nB = has_next ? (const char*)g.Bt + (size_t)nxt.pn * tstep + (size_t)nxt.k0 * 2 : cB;
        const int nt = cur.kn;
        for (int t = 0; t < nt; t += 2) {
            const bool last = (t == nt - 2);
            const char* a1 = cA + (size_t)(t + 1) * kstep;
            const char* a2 = last ? nA : cA + (size_t)(t + 2) * kstep; const char* b2 = last ? nB : cB + (size_t)(t + 2) * kstep;
            const char* a3 = a2 + kstep; const char* b3 = b2 + kstep;
            if (last && has_next) S.a_ready(nxt);
            if constexpr (SP2) {
            PG8_LDB(B0, 0, 0); PG8_LDB(B1, 0, 1); PG8_SCHED; PG8_LDA(At, 0, 0); PG8_STAGE(PG8_SA(1, 1), a1 + hstep, voffA);
            PG8_WAIT_V(8); PG8_WAIT_L(0); PG8_BAR; PG8_MMA(0, 0, At, B0); PG8_MMA(0, 1, At, B1); PG8_BAR; PG8_SCHED;
            PG8_LDA(At, 0, 1); PG8_STAGE(PG8_SB(0, 0), b2, voffB); PG8_STAGE(PG8_SB(0, 1), b2 + hstep, voffB); PG8_STAGE(PG8_SA(0, 0), a2, voffA);
            PG8_WAIT_V(8); PG8_WAIT_L(0); PG8_BAR; PG8_MMA(1, 0, At, B0); PG8_MMA(1, 1, At, B1); PG8_BAR; PG8_SCHED;
            PG8_LDB(B0, 1, 0); PG8_LDB(B1, 1, 1); PG8_SCHED; PG8_LDA(At, 1, 0); PG8_STAGE(PG8_SA(0, 1), a2 + hstep, voffA);
            PG8_WAIT_V(8); PG8_WAIT_L(0); PG8_BAR; PG8_MMA(0, 0, At, B0); PG8_MMA(0, 1, At, B1); PG8_BAR; PG8_SCHED;
            PG8_LDA(At, 1, 1); PG8_STAGE(PG8_SB(1, 0), b3, voffB); PG8_STAGE(PG8_SB(1, 1), b3 + hstep, voffB); PG8_STAGE(PG8_SA(1, 0), a3, voffA);
            PG8_WAIT_V(8); PG8_WAIT_L(0); PG8_BAR; PG8_MMA(1, 0, At, B0); PG8_MMA(1, 1, At, B1); PG8_BAR; PG8_SCHED;
            } else {
            PG8_LDB(B0, 0, 0); PG8_SCHED; PG8_LDA(At, 0, 0); PG8_STAGE(PG8_SA(1, 1), a1 + hstep, voffA);
            PG8_WAIT_L(8); PG8_BAR; PG8_WAIT_L(0); PG8_MMA(0, 0, At, B0); PG8_BAR; PG8_SCHED;
            PG8_LDB(B1, 0, 1); PG8_STAGE(PG8_SB(0, 0), b2, voffB);
            PG8_BAR; PG8_WAIT_L(0); PG8_MMA(0, 1, At, B1); PG8_BAR;
            PG8_LDA(At, 0, 1); PG8_STAGE(PG8_SA(0, 0), a2, voffA);
            PG8_BAR; PG8_WAIT_L(0); PG8_MMA(1, 0, At, B0); PG8_BAR; PG8_SCHED;
            PG8_STAGE(PG8_SB(0, 1), b2 + hstep, voffB);
            PG8_WAIT_V(6); PG8_BAR; PG8_MMA(1, 1, At, B1); PG8_BAR;
            PG8_LDB(B0, 1, 0); PG8_SCHED; PG8_LDA(At, 1, 0); PG8_STAGE(PG8_SA(0, 1), a2 + hstep, voffA);
            PG8_WAIT_L(8); PG8_BAR; PG8_WAIT_L(0); PG8_MMA(0, 0, At, B0); PG8_BAR; PG8_SCHED;
            PG8_LDB(B1, 1, 1); PG8_STAGE(PG8_SB(1, 0), b3, voffB);
            PG8_BAR; PG8_WAIT_L(0); PG8_MMA(0, 1, At, B1); PG8_BAR;
            PG8_LDA(At, 1, 1); PG8_STAGE(PG8_SA(1, 0), a3, voffA);
            PG8_BAR; PG8_WAIT_L(0); PG8_MMA(1, 0, At, B0); PG8_BAR; PG8_SCHED;
            PG8_STAGE(PG8_SB(1, 1), b3 + hstep, voffB);
            PG8_WAIT_V(6); PG8_BAR; PG8_MMA(1, 1, At, B1); PG8_BAR;
            }
        }
        if constexpr (ALIGN_EPI) { if (wr == 0) PG8_BAR; }
        if constexpr (!Epi::AFTER_DRAIN) { E(acc, cur, wr, wc, fr, fq); S.done(cur); }
        if (!has_next) break;
#pragma unroll
        for (int a = 0; a < 2; ++a)
#pragma unroll
            for (int b = 0; b < 2; ++b)
#pragma unroll
                for (int m = 0; m < 4; ++m)
#pragma unroll
                    for (int n = 0; n < 2; ++n) acc[a][b][m][n] = (f32x4){0.f, 0.f, 0.f, 0.f};
        cur = nxt; cA = nA; cB = nB; ++ui;
        if constexpr (ALIGN_EPI) { if (wr == 1) PG8_BAR; }
    }
    PG8_WAIT_V(0);
    if constexpr (!ALIGN_EPI) { if (wr == 0) PG8_BAR; }
    PG8_BAR;
    if constexpr (Epi::AFTER_DRAIN) { E.fused(acc, cur, wr, wc, fr, fq, lds, wid, lane); S.done(cur); }
#undef PG8_SA
#undef PG8_SB
#undef PG8_STAGE
#undef PG8_LDA
#undef PG8_LDB
#undef PG8_MMA
#undef PG8_WAIT_V
#undef PG8_WAIT_L
#undef PG8_BAR
#undef PG8_SCHED
}
}

#ifndef REP_ATT
#define REP_ATT 1
#endif
#ifndef REP_GEMM
#define REP_GEMM 1
#endif
#ifndef REP_ROW
#define REP_ROW 1
#endif
#ifndef REP_SYNC
#define REP_SYNC 0
#endif
#ifndef REP_ALL
#define REP_ALL 1
#endif
#ifndef REP_P0
#define REP_P0 1
#endif
constexpr int DM = 1024, NB = 8, SEQ = 2048, DB = 16, DSEQ = 64, PAST = 2048;
constexpr int MP = NB * SEQ, MS = DB * DSEQ, MT = MP + MS;
constexpr int NIN = 3072, DFF = 4096, NMOD = 6 * DM;
constexpr float EPS = 1e-6f;
constexpr float LOG2E = 1.4426950408889634f;
constexpr size_t O_KVP = (size_t)MT * DM;
constexpr size_t KVP_SZ = (size_t)MP * 512;
constexpr size_t O_KVS = O_KVP + 4 * KVP_SZ;
constexpr size_t KVS_SZ = (size_t)MS * 512;
constexpr size_t MiB = 1u << 20;
constexpr size_t WS_CTL = 0, WS_MOD = 1 * MiB, WS_WIN = 2 * MiB, WS_WOUT = 8 * MiB, WS_WUP = 10 * MiB, WS_WDN = 18 * MiB;
constexpr size_t WS_XN = 26 * MiB, WS_U = 60 * MiB, WS_MIX = 162 * MiB, WS_HB = 60 * MiB, WS_Y = 196 * MiB, WS_END = 264 * MiB;
static_assert(WS_XN + (size_t)MT * DM * 2 <= WS_U && WS_U + (size_t)MT * NIN * 2 <= WS_MIX && WS_MIX + (size_t)MT * DM * 2 <= WS_Y && WS_HB + (size_t)MT * DFF * 2 <= WS_Y && WS_Y + (size_t)MT * DM * 4 <= WS_END, "ws map");
constexpr size_t WS_YP = 264 * MiB, WS_END2 = 328 * MiB;
constexpr int NSPLIT_O = 8, NSPLIT_D = 16;
constexpr int LDS_BYTES = 131072 + 1024;
constexpr int LDS_MISC = 131072;
constexpr int CW_BAR = 4096;
constexpr size_t CTL_ZERO_BYTES = 65536;

#define LAS __attribute__((address_space(3)))
#define DI __device__ __forceinline__
typedef unsigned short bf16_t;
typedef short bf16x8 __attribute__((ext_vector_type(8)));
typedef short s16x4 __attribute__((ext_vector_type(4)));
typedef float f32x4 __attribute__((ext_vector_type(4)));
typedef float f32x16 __attribute__((ext_vector_type(16)));
typedef unsigned u32x4 __attribute__((ext_vector_type(4)));
typedef unsigned u32x2 __attribute__((ext_vector_type(2)));
typedef float f32x2_t __attribute__((ext_vector_type(2)));
typedef __bf16 bf16x2_t __attribute__((ext_vector_type(2)));
DI unsigned cvtpk(float lo, float hi) { f32x2_t v = {lo, hi}; bf16x2_t b = __builtin_convertvector(v, bf16x2_t); return __builtin_bit_cast(unsigned, b); }
#define LDS_WAIT() asm volatile("s_waitcnt lgkmcnt(0)" ::: "memory")

namespace pg8 {
struct EpiQKV {
    static constexpr bool PERM = true, AFTER_DRAIN = false;
    bf16_t* U; float* out;
    __device__ __forceinline__ void operator()(const f32x4 (&acc)[2][2][4][2], const Unit& u, int wr, int wc, int fr, int fq) const {
        const int sec = u.pn >> 1;
        const bool kv = (sec == 1) || (sec == 2) || (sec == 4) || (sec == 5);
        const int kvi = (sec == 1) ? 0 : (sec == 2) ? 1 : (sec == 4) ? 2 : 3;
        const bool prompt = u.pm < (MP / BM);
        const float qs = (sec == 0 || sec == 3) ? 0.125f * LOG2E : 1.f;
        float* fbase = prompt ? out + O_KVP + (size_t)kvi * KVP_SZ : out + O_KVS + (size_t)kvi * KVS_SZ - (size_t)MP * 512;
        const int row0 = u.pm * BM + wr * 64 + fr, col0 = u.pn * BM + wc * 32 + 8 * fq, colsec = col0 - sec * 512;
#pragma unroll
        for (int ai = 0; ai < 2; ++ai)
#pragma unroll
            for (int m = 0; m < 4; ++m) { const int row = row0 + ai * HALF + m * 16;
#pragma unroll
                for (int bj = 0; bj < 2; ++bj) { const f32x4 v0 = acc[ai][bj][m][0], v1 = acc[ai][bj][m][1];
                    const f32x4 s0 = v0 * qs, s1 = v1 * qs;
                    u32x4 w; w.x = cvt_pk_bf16(s0[0], s0[1]); w.y = cvt_pk_bf16(s0[2], s0[3]); w.z = cvt_pk_bf16(s1[0], s1[1]); w.w = cvt_pk_bf16(s1[2], s1[3]);
                    *(u32x4*)(U + (size_t)row * NIN + col0 + bj * HALF) = w;
                    if (kv) { float* d = fbase + (size_t)row * 512 + colsec + bj * HALF; *(f32x4*)d = v0; *(f32x4*)(d + 4) = v1; } } }
    }
};
struct EpiF32 {
    static constexpr bool PERM = true, AFTER_DRAIN = false;
    float* Y; int ldc; float* Ypart;
    __device__ __forceinline__ void operator()(const f32x4 (&acc)[2][2][4][2], const Unit& u, int wr, int wc, int fr, int fq) const {
        const int row0 = u.pm * BM + wr * 64 + fr, col0 = u.pn * BM + wc * 32 + 8 * fq;
        float* base = (u.ks < 0) ? Y : Ypart + ((size_t)u.ks * MS - MP) * (size_t)ldc;
#pragma unroll
        for (int ai = 0; ai < 2; ++ai)
#pragma unroll
            for (int m = 0; m < 4; ++m) { float* rowp = base + (size_t)(row0 + ai * HALF + m * 16) * ldc + col0;
#pragma unroll
                for (int bj = 0; bj < 2; ++bj) { *(f32x4*)(rowp + bj * HALF) = acc[ai][bj][m][0]; *(f32x4*)(rowp + bj * HALF + 4) = acc[ai][bj][m][1]; } }
    }
};
struct EpiRelu2 {
    static constexpr bool PERM = true, AFTER_DRAIN = false;
    bf16_t* O; int ldc;
    __device__ __forceinline__ void operator()(const f32x4 (&acc)[2][2][4][2], const Unit& u, int wr, int wc, int fr, int fq) const {
        const int row0 = u.pm * BM + wr * 64 + fr, col0 = u.pn * BM + wc * 32 + 8 * fq;
#pragma unroll
        for (int ai = 0; ai < 2; ++ai)
#pragma unroll
            for (int m = 0; m < 4; ++m) { bf16_t* rowp = O + (size_t)(row0 + ai * HALF + m * 16) * ldc + col0;
#pragma unroll
                for (int bj = 0; bj < 2; ++bj) { f32x4 v0 = acc[ai][bj][m][0], v1 = acc[ai][bj][m][1];
                    v0 = __builtin_elementwise_max(v0, (f32x4){0.f, 0.f, 0.f, 0.f}); v1 = __builtin_elementwise_max(v1, (f32x4){0.f, 0.f, 0.f, 0.f}); v0 = v0 * v0; v1 = v1 * v1;
                    u32x4 w; w.x = cvt_pk_bf16(v0[0], v0[1]); w.y = cvt_pk_bf16(v0[2], v0[3]); w.z = cvt_pk_bf16(v1[0], v1[1]); w.w = cvt_pk_bf16(v1[2], v1[3]);
                    *(u32x4*)(rowp + bj * HALF) = w; } }
    }
};
}

DI float wave_sum(float v) {
#pragma unroll
    for (int o = 1; o < 64; o <<= 1) v += __shfl_xor(v, o);
    return v;
}
DI unsigned f2bf(float f) { unsigned u = __builtin_bit_cast(unsigned, f); return (u + 0x7fffu + ((u >> 16) & 1u)) >> 16; }
DI unsigned pk2(float lo, float hi) { return f2bf(lo) | (f2bf(hi) << 16); }
DI float xswap_add(float v) { auto rr = __builtin_amdgcn_permlane32_swap(__float_as_uint(v), __float_as_uint(v), false, false); return __uint_as_float(rr[0]) + __uint_as_float(rr[1]); }
DI float xswap_max(float v) { auto rr = __builtin_amdgcn_permlane32_swap(__float_as_uint(v), __float_as_uint(v), false, false); return fmaxf(__uint_as_float(rr[0]), __uint_as_float(rr[1])); }

DI void p0_transpose_item(const float* W, int K, int N, bf16_t* WT, LAS float* scr, int item, int lane) {
    const int nblk = N / 32, kb = item / nblk, nb = item % nblk, k0 = 64 * kb, n0 = 32 * nb;
    float tv[32];
#pragma unroll
    for (int i = 0; i < 32; ++i) tv[i] = W[(size_t)(k0 + 2 * i + (lane >> 5)) * N + n0 + (lane & 31)];
#pragma unroll
    for (int i = 0; i < 32; ++i) scr[(2 * i + (lane >> 5)) * 33 + (lane & 31)] = tv[i];
    LDS_WAIT();
    const int c = lane & 7;
#pragma unroll
    for (int j = 0; j < 4; ++j) { const int n = (lane >> 3) + 8 * j; const LAS float* s = scr + (8 * c) * 33 + n;
        u32x4 o; o.x = pk2(s[0 * 33], s[1 * 33]); o.y = pk2(s[2 * 33], s[3 * 33]); o.z = pk2(s[4 * 33], s[5 * 33]); o.w = pk2(s[6 * 33], s[7 * 33]);
        *(u32x4*)(WT + (size_t)(n0 + n) * K + k0 + 8 * c) = o; }
    LDS_WAIT();
}
DI void p0_modulate_block(const float* cp, const float* cs, const float* w_ada, const float* b_ada, float* mod, LAS unsigned char* lds, int item, int tid, int lane, int wave) {
    LAS float* scr = (LAS float*)(lds + wave * 16384);
    LAS float* red = (LAS float*)(lds + wave * 16384 + 12288);
#pragma unroll 8
    for (int e = lane; e < 24 * 128; e += 64) { const int bi = e >> 7, j = e & 127;
        const float v = (bi < 8) ? cp[bi * DM + 128 * wave + j] : cs[(bi - 8) * DM + 128 * wave + j];
        scr[e] = v / (1.f + __expf(-v)); }
    LDS_WAIT();
    const int kh = lane >> 5;
    const float* wp = w_ada + (size_t)(128 * wave + 64 * kh) * NMOD + item * 32 + (lane & 31);
    float acc[24];
#pragma unroll
    for (int bi = 0; bi < 24; ++bi) acc[bi] = 0.f;
#pragma unroll 4
    for (int j4 = 0; j4 < 16; ++j4) {
        float wv[4];
#pragma unroll
        for (int q = 0; q < 4; ++q) wv[q] = wp[(size_t)(4 * j4 + q) * NMOD];
#pragma unroll
        for (int bi = 0; bi < 24; ++bi) { const f32x4 sv = *(const LAS f32x4*)(scr + bi * 128 + 64 * kh + 4 * j4); acc[bi] += (sv.x * wv[0] + sv.y * wv[1]) + (sv.z * wv[2] + sv.w * wv[3]); }
    }
#pragma unroll
    for (int bi = 0; bi < 24; ++bi) acc[bi] += __shfl_xor(acc[bi], 32);
    if (lane < 32) {
#pragma unroll
        for (int bi = 0; bi < 24; ++bi) red[bi * 32 + lane] = acc[bi]; }
    __syncthreads();
    for (int e = tid; e < 24 * 32; e += 512) { float sum = 0.f;
#pragma unroll
        for (int w8 = 0; w8 < 8; ++w8) sum += ((const LAS float*)(lds + w8 * 16384 + 12288))[e];
        const int c = item * 32 + (e & 31); mod[(e >> 5) * NMOD + c] = sum + b_ada[c]; }
    __syncthreads();
}

DI int row_bi(int row) { return row < MP ? (row >> 11) : 8 + ((row - MP) >> 6); }
DI void p1_row(const float* xrow, const float* mod, const float* g, bf16_t* orow, int bi, int lane) {
    const f32x4* xr = (const f32x4*)xrow + lane; f32x4 v[4]; float s = 0.f;
#pragma unroll
    for (int j = 0; j < 4; ++j) { v[j] = xr[64 * j]; s += (v[j].x * v[j].x + v[j].y * v[j].y) + (v[j].z * v[j].z + v[j].w * v[j].w); }
    const float r = rsqrtf(wave_sum(s) * (1.f / DM) + EPS);
    const f32x4* gg = (const f32x4*)g + lane; const f32x4* sh = (const f32x4*)(mod + (size_t)bi * NMOD) + lane; const f32x4* sc = (const f32x4*)(mod + (size_t)bi * NMOD + DM) + lane;
    u32x2* o8 = (u32x2*)orow + lane;
#pragma unroll
    for (int j = 0; j < 4; ++j) { const f32x4 h = v[j] * r * gg[64 * j] * (sc[64 * j] + 1.f) + sh[64 * j]; u32x2 w; w.x = cvtpk(h.x, h.y); w.y = cvtpk(h.z, h.w); o8[64 * j] = w; }
}
DI f32x4 load_y(const void* yrow, int nsum, int lane, int j) {
    const f32x4* yr = (const f32x4*)yrow + lane + 64 * j; f32x4 y = yr[0];
    for (int k = 1; k < nsum; ++k) y = y + yr[(size_t)k * (MS * DM / 4)];
    return y;
}
DI void p5_row(const float* xrow, const void* yrow, int nsum, const float* mod, const float* gpost, const float* gpre2, float* outrow, bf16_t* xnrow, int bi, int lane) {
    const f32x4* xr = (const f32x4*)xrow + lane; f32x4 y[4], x1[4]; float s = 0.f;
#pragma unroll
    for (int j = 0; j < 4; ++j) { y[j] = load_y(yrow, nsum, lane, j);
        s += (y[j].x * y[j].x + y[j].y * y[j].y) + (y[j].z * y[j].z + y[j].w * y[j].w); }
    const float r1 = rsqrtf(wave_sum(s) * (1.f / DM) + EPS);
    const float* mb = mod + (size_t)bi * NMOD;
    const f32x4* gp = (const f32x4*)gpost + lane; const f32x4* ga = (const f32x4*)(mb + 2 * DM) + lane;
    float s2 = 0.f; f32x4* orow = (f32x4*)outrow + lane;
#pragma unroll
    for (int j = 0; j < 4; ++j) { x1[j] = xr[64 * j] + ga[64 * j] * (y[j] * r1 * gp[64 * j]); orow[64 * j] = x1[j];
        s2 += (x1[j].x * x1[j].x + x1[j].y * x1[j].y) + (x1[j].z * x1[j].z + x1[j].w * x1[j].w); }
    const float r2 = rsqrtf(wave_sum(s2) * (1.f / DM) + EPS);
    const f32x4* g2 = (const f32x4*)gpre2 + lane; const f32x4* sh = (const f32x4*)(mb + 3 * DM) + lane; const f32x4* sc = (const f32x4*)(mb + 4 * DM) + lane;
    u32x2* o8 = (u32x2*)xnrow + lane;
#pragma unroll
    for (int j = 0; j < 4; ++j) { const f32x4 h = x1[j] * r2 * g2[64 * j] * (sc[64 * j] + 1.f) + sh[64 * j]; u32x2 w; w.x = cvtpk(h.x, h.y); w.y = cvtpk(h.z, h.w); o8[64 * j] = w; }
}
DI void p8_row(const void* yrow, int nsum, const float* mod, const float* gpost, float* outrow, int bi, int lane) {
    f32x4 y[4]; float s = 0.f;
#pragma unroll
    for (int j = 0; j < 4; ++j) { y[j] = load_y(yrow, nsum, lane, j);
        s += (y[j].x * y[j].x + y[j].y * y[j].y) + (y[j].z * y[j].z + y[j].w * y[j].w); }
    const float r1 = rsqrtf(wave_sum(s) * (1.f / DM) + EPS);
    const f32x4* gp = (const f32x4*)gpost + lane; const f32x4* ga = (const f32x4*)(mod + (size_t)bi * NMOD + 5 * DM) + lane; f32x4* orow = (f32x4*)outrow + lane;
#pragma unroll
    for (int j = 0; j < 4; ++j) orow[64 * j] = orow[64 * j] + ga[64 * j] * (y[j] * r1 * gp[64 * j]);
}

namespace att {
#define MFMA32(a, b, c) __builtin_amdgcn_mfma_f32_32x32x16_bf16((a), (b), (c), 0, 0, 0)
typedef short v4i16_t __attribute__((ext_vector_type(4)));
DI unsigned off_b(unsigned row, unsigned ch) { return 256u * row + 16u * (ch ^ (((row & 3u) << 2) | ((row >> 2) & 3u))); }
DI s16x4 trr(const LAS char* p) { return __builtin_bit_cast(s16x4, __builtin_amdgcn_ds_read_tr16_b64_v4i16((LAS v4i16_t*)p)); }
DI bf16x8 cat8(s16x4 lo, s16x4 hi) { return (bf16x8){lo[0], lo[1], lo[2], lo[3], hi[0], hi[1], hi[2], hi[3]}; }
template <int S> DI bf16x8 pack8(const f32x16& x) { u32x4 p; p[0] = cvtpk(x[8 * S], x[8 * S + 1]); p[1] = cvtpk(x[8 * S + 2], x[8 * S + 3]); p[2] = cvtpk(x[8 * S + 4], x[8 * S + 5]); p[3] = cvtpk(x[8 * S + 6], x[8 * S + 7]); return __builtin_bit_cast(bf16x8, p); }
DI u32x4 cvt8(u32x4 a, u32x4 b) {
    u32x4 o; o.x = cvtpk(__uint_as_float(a.x), __uint_as_float(a.y)); o.y = cvtpk(__uint_as_float(a.z), __uint_as_float(a.w));
    o.z = cvtpk(__uint_as_float(b.x), __uint_as_float(b.y)); o.w = cvtpk(__uint_as_float(b.z), __uint_as_float(b.w)); return o; }

struct Ctx {
    const bf16_t* U; bf16_t* MIX;
    const float *cdk, *cdv, *csk, *csv;
    const float* subg; float lam;
};

DI void diff_unit(const Ctx& C, LAS char* lds, bool sample, int b, int hh, int u) {
    int tid_ = threadIdx.x; asm volatile("" : "+v"(tid_));
    const int tid = tid_, lane = tid & 63, r = lane & 31, h = lane >> 5, w = __builtin_amdgcn_readfirstlane(tid >> 6);
    const int qblk = w >> 1, map = w & 1;
    const bool active = sample ? (w < 4) : true;
    const int ncache = sample ? 32 : 0;
    const int tokbase = sample ? MP + b * DSEQ : b * SEQ;
    const int cbase = b * PAST;
    const int Tmax = sample ? 32 : 2 * u + 1;
    const int qrel = sample ? 32 * qblk : 128 * u + 32 * qblk;
    const int Tw = sample ? 32 : (qrel >> 6);
    const int qpos = (sample ? PAST : 0) + qrel + r;
    const int qrow = tokbase + (active ? qrel : 0) + r;
    bf16x8 qf[4];
#pragma unroll
    for (int ds = 0; ds < 4; ++ds) qf[ds] = *(const bf16x8*)(C.U + (size_t)qrow * NIN + hh * 128 + map * 64 + 16 * ds + 8 * h);
    unsigned kaddr[4];
    { const unsigned x = ((r & 3u) << 2) | ((r >> 2) & 3u);
#pragma unroll
      for (int ds = 0; ds < 4; ++ds) kaddr[ds] = 256u * r + 16u * ((unsigned)(2 * (4 * map + ds) + h) ^ x); }
    unsigned vaddr[2][4];
    { const unsigned blk = (lane >> 4) & 1, q = (lane & 15) >> 2, p = lane & 3;
#pragma unroll
      for (int t = 0; t < 2; ++t)
#pragma unroll
          for (int c = 0; c < 4; ++c) vaddr[t][c] = off_b(8 * t + 4 * h + q, 4 * c + 2 * blk + (p >> 1)) + 8 * (p & 1); }
    const int srow = tid >> 4, sch = tid & 15;
    const unsigned sdst0 = off_b(srow, sch), sdst1 = off_b(srow + 32, sch);
    u32x4 st[4];
    auto issue_bf = [&](int t) {
        const bf16_t* g0 = C.U + (size_t)(tokbase + 64 * (t - ncache) + srow) * NIN + hh * 128 + sch * 8 + 512; const bf16_t* g1 = g0 + (size_t)32 * NIN;
        st[0] = *(const u32x4*)g0; st[1] = *(const u32x4*)g1; st[2] = *(const u32x4*)(g0 + 512); st[3] = *(const u32x4*)(g1 + 512);
    };
    auto commit_bf = [&](int buf) {
        LAS char* kimg = lds + buf * 32768; LAS char* vimg = kimg + 16384;
        *(LAS u32x4*)(kimg + sdst0) = st[0]; *(LAS u32x4*)(kimg + sdst1) = st[1]; *(LAS u32x4*)(vimg + sdst0) = st[2]; *(LAS u32x4*)(vimg + sdst1) = st[3];
    };
    auto issue_f32 = [&](int t, int isv) {
        const float* src = isv ? C.cdv : C.cdk;
        const size_t o0 = (size_t)(cbase + 64 * t + srow) * 512 + hh * 128 + sch * 8, o1 = o0 + (size_t)32 * 512;
        st[0] = *(const u32x4*)(src + o0); st[1] = *(const u32x4*)(src + o0 + 4); st[2] = *(const u32x4*)(src + o1); st[3] = *(const u32x4*)(src + o1 + 4);
    };
    auto commit_f32 = [&](int buf, int isv) {
        LAS char* img = lds + buf * 32768 + (isv ? 16384 : 0);
        *(LAS u32x4*)(img + sdst0) = cvt8(st[0], st[1]); *(LAS u32x4*)(img + sdst1) = cvt8(st[2], st[3]);
    };
    const float slope = __builtin_amdgcn_exp2f(-2.f * (float)(hh + 1));
    const float sl2 = slope * LOG2E;
    f32x16 o[4];
#pragma unroll
    for (int dt = 0; dt < 4; ++dt)
#pragma unroll
        for (int i = 0; i < 16; ++i) o[dt][i] = 0.f;
    float mrun = 0.f, lrun = 0.f;

    if (Tmax < ncache) { issue_f32(Tmax, 0); commit_f32(0, 0); issue_f32(Tmax, 1); commit_f32(0, 1); } else { issue_bf(Tmax); commit_bf(0); }
    __syncthreads();
    int cur = 0;
    for (int t = Tmax; t >= 0; --t) {
        const bool comp = active && t <= Tw;
        const bool nf32 = (t - 1) < ncache;
        const LAS char* kimg = lds + cur * 32768; const LAS char* vimg = kimg + 16384;
        bf16x8 P[4];
        if (t > 0) { if (nf32) issue_f32(t - 1, 0); else issue_bf(t - 1); }
        if (comp) {
            const bool diag = (t == Tw);
            f32x16 s0, s1;
            const float kb0 = sl2 * (float)(64 * t + 4 * h) - mrun;
            if (!diag) {
#pragma unroll
                for (int i = 0; i < 16; ++i) { const float ci = (float)((i & 3) + 8 * (i >> 2)); s0[i] = __builtin_fmaf(sl2, ci, kb0); s1[i] = __builtin_fmaf(sl2, ci + 32.f, kb0); }
            } else {
                float dq = (float)(qpos - 64 * t - 4 * h); asm volatile("" : "+v"(dq));
                const float m2 = -2.f * sl2;
#pragma unroll
                for (int i = 0; i < 16; ++i) { const float ci = (float)((i & 3) + 8 * (i >> 2));
                    s0[i] = __builtin_fmaf(m2, fmaxf(ci - dq, 0.f), __builtin_fmaf(sl2, ci, kb0)); s1[i] = __builtin_fmaf(m2, fmaxf(ci + 32.f - dq, 0.f), __builtin_fmaf(sl2, ci + 32.f, kb0)); }
            }
#pragma unroll
            for (int ds = 0; ds < 4; ++ds) {
                const bf16x8 k0 = *(const LAS bf16x8*)(kimg + kaddr[ds]); const bf16x8 k1 = *(const LAS bf16x8*)(kimg + kaddr[ds] + 8192);
                s0 = MFMA32(k0, qf[ds], s0); s1 = MFMA32(k1, qf[ds], s1); }
            float mx = fmaxf(s0[0], s1[0]);
#pragma unroll
            for (int i = 1; i < 16; ++i) mx = fmaxf(mx, fmaxf(s0[i], s1[i]));
            mx = xswap_max(mx);
            if (diag || __any(mx > 0.f)) {
                const float dl = diag ? mx : fmaxf(mx, 0.f), alpha = diag ? 0.f : __builtin_amdgcn_exp2f(-dl); mrun += dl; lrun *= alpha;
#pragma unroll
                for (int i = 0; i < 16; ++i) { s0[i] -= dl; s1[i] -= dl; }
#pragma unroll
                for (int dt = 0; dt < 4; ++dt)
#pragma unroll
                    for (int i = 0; i < 16; ++i) o[dt][i] *= alpha; }
            float ps = 0.f;
#pragma unroll
            for (int i = 0; i < 16; ++i) { s0[i] = __builtin_amdgcn_exp2f(s0[i]); s1[i] = __builtin_amdgcn_exp2f(s1[i]); ps += s0[i] + s1[i]; }
            lrun += ps;
            P[0] = pack8<0>(s0); P[1] = pack8<1>(s0); P[2] = pack8<0>(s1); P[3] = pack8<1>(s1);
        }
        if (t > 0 && nf32) { commit_f32(cur ^ 1, 0); issue_f32(t - 1, 1); }
        if (comp) {
#pragma unroll
            for (int dt = 0; dt < 4; ++dt)
#pragma unroll
                for (int ks = 0; ks < 4; ++ks) { const s16x4 lo = trr(vimg + vaddr[0][dt] + 4096 * ks), hi = trr(vimg + vaddr[1][dt] + 4096 * ks);
                    o[dt] = MFMA32(cat8(lo, hi), P[ks], o[dt]); }
        }
        if (t > 0) { if (nf32) commit_f32(cur ^ 1, 1); else commit_bf(cur ^ 1); }
        __syncthreads();
        cur ^= 1;
    }
    const float inv = 1.f / xswap_add(lrun);
    LAS float* X = (LAS float*)(lds + (w >> 1) * 16384);
    if (active && map == 1) { const float f = C.lam * inv;
#pragma unroll
        for (int dt = 0; dt < 4; ++dt)
#pragma unroll
            for (int i = 0; i < 16; ++i) X[(dt * 16 + i) * 64 + lane] = o[dt][i] * f; }
    __syncthreads();
    if (active && map == 0) { float ss = 0.f;
#pragma unroll
        for (int dt = 0; dt < 4; ++dt)
#pragma unroll
            for (int i = 0; i < 16; ++i) { const float v = o[dt][i] * inv - X[(dt * 16 + i) * 64 + lane]; o[dt][i] = v; ss += v * v; }
        ss = xswap_add(ss);
        const float rn = rsqrtf(ss * (1.f / 128.f) + EPS) * 0.8f;
        bf16_t* orow = C.MIX + (size_t)qrow * DM + hh * 128;
#pragma unroll
        for (int dt = 0; dt < 4; ++dt)
#pragma unroll
            for (int g = 0; g < 4; ++g) { const int d = 32 * dt + 8 * g + 4 * h; const f32x4 gg = *(const f32x4*)(C.subg + d);
                u32x2 wv; wv.x = cvtpk(o[dt][4 * g] * rn * gg.x, o[dt][4 * g + 1] * rn * gg.y); wv.y = cvtpk(o[dt][4 * g + 2] * rn * gg.z, o[dt][4 * g + 3] * rn * gg.w);
                *(u32x2*)(orow + d) = wv; } }
    __syncthreads();
}

constexpr float SB_THR = -150.f;
DI void sb_unit(const Ctx& C, LAS char* lds, bool sample, int b, int hh, int qb) {
    int tid_ = threadIdx.x; asm volatile("" : "+v"(tid_));
    const int tid = tid_, lane = tid & 63, r = lane & 31, h = lane >> 5, w = __builtin_amdgcn_readfirstlane(tid >> 6);
    const bool active = sample ? (w < 2) : true;
    const int ncache = sample ? 32 : 0;
    const int tokbase = sample ? MP + b * DSEQ : b * SEQ;
    const int cbase = b * PAST;
    const int Tmax = sample ? 32 : 4 * qb + 3;
    const int qrel = sample ? 32 * w : 256 * qb + 32 * w;
    const int Tw = sample ? 32 : (qrel >> 6);
    const int qi = (qrel & 63) + r;
    const int qrow = tokbase + (active ? qrel : 0) + r;
    LAS unsigned* flags = (LAS unsigned*)(lds + 32768);
    bf16x8 qf[4];
#pragma unroll
    for (int ds = 0; ds < 4; ++ds) qf[ds] = *(const bf16x8*)(C.U + (size_t)qrow * NIN + 1536 + hh * 64 + 16 * ds + 8 * h);
    unsigned kaddr[4];
    { const unsigned x = ((r & 3u) << 2) | ((r >> 2) & 3u);
#pragma unroll
      for (int ds = 0; ds < 4; ++ds) kaddr[ds] = 256u * r + 16u * ((unsigned)(2 * ds + h) ^ x); }
    unsigned vaddr[2][2];
    { const unsigned blk = (lane >> 4) & 1, q = (lane & 15) >> 2, p = lane & 3;
#pragma unroll
      for (int t = 0; t < 2; ++t)
#pragma unroll
          for (int c = 0; c < 2; ++c) vaddr[t][c] = off_b(8 * t + 4 * h + q, 4 * (c + 2) + 2 * blk + (p >> 1)) + 8 * (p & 1); }
    bf16x8 tri[2];
#pragma unroll
    for (int s = 0; s < 2; ++s)
#pragma unroll
        for (int j = 0; j < 8; ++j) tri[s][j] = ((16 * s + 8 * (j >> 2) + 4 * h + (j & 3)) > r) ? (short)0x3F80 : (short)0;
    const int srow = tid >> 4, sch = tid & 15;
    const unsigned sdst0 = off_b(srow, sch), sdst1 = off_b(srow + 32, sch);
    const int scol = (sch < 8) ? (2048 + hh * 64 + sch * 8) : (2560 + hh * 64 + (sch - 8) * 8);
    const float* csrc = (sch < 8) ? C.csk : C.csv;
    u32x4 st[4];
    auto issue = [&](int t) {
        if (t < ncache) {
            const size_t o0 = (size_t)(cbase + 64 * t + srow) * 512 + hh * 64 + (sch & 7) * 8, o1 = o0 + (size_t)32 * 512;
            st[0] = *(const u32x4*)(csrc + o0); st[1] = *(const u32x4*)(csrc + o0 + 4); st[2] = *(const u32x4*)(csrc + o1); st[3] = *(const u32x4*)(csrc + o1 + 4);
        } else {
            const bf16_t* g0 = C.U + (size_t)(tokbase + 64 * (t - ncache) + srow) * NIN + scol;
            st[0] = *(const u32x4*)g0; st[1] = *(const u32x4*)(g0 + (size_t)32 * NIN);
        }
    };
    auto commit = [&](int t, int buf) {
        LAS char* img = lds + buf * 16384;
        if (t < ncache) { *(LAS u32x4*)(img + sdst0) = cvt8(st[0], st[1]); *(LAS u32x4*)(img + sdst1) = cvt8(st[2], st[3]); }
        else { *(LAS u32x4*)(img + sdst0) = st[0]; *(LAS u32x4*)(img + sdst1) = st[1]; }
    };
    f32x16 o[2];
#pragma unroll
    for (int dt = 0; dt < 2; ++dt)
#pragma unroll
        for (int i = 0; i < 16; ++i) o[dt][i] = 0.f;
    float R = 0.f;

    issue(Tmax); commit(Tmax, 0); __syncthreads();
    int cur = 0;
    for (int t = Tmax; t >= 0; --t) {
        if (t > 0) issue(t - 1);
        unsigned done = active ? 0u : 1u;
        if (active && t <= Tw) {
            const LAS char* img = lds + cur * 16384;
            const bool diag = (t == Tw);
            bf16x8 P[4];
            float carry = R;
            float tsum = 0.f;
#define SB_HALF(KT) { \
                f32x16 z; _Pragma("unroll") for (int i = 0; i < 16; ++i) z[i] = 0.f; \
                _Pragma("unroll") for (int ds = 0; ds < 4; ++ds) { const bf16x8 kf = *(const LAS bf16x8*)(img + kaddr[ds] + 8192 * (KT)); z = MFMA32(kf, qf[ds], z); } \
                f32x16 ln; float sm = 0.f; \
                if (!diag) { \
                    _Pragma("unroll") for (int i = 0; i < 16; ++i) { const float e = __builtin_amdgcn_exp2f(-fabsf(z[i])); \
                        const float sp = fmaxf(z[i], 0.f) + __builtin_amdgcn_logf(1.f + e); ln[i] = -sp; z[i] -= sp; sm -= sp; } \
                } else { \
                    _Pragma("unroll") for (int i = 0; i < 16; ++i) { const float e = __builtin_amdgcn_exp2f(-fabsf(z[i])); \
                        const float sp = fmaxf(z[i], 0.f) + __builtin_amdgcn_logf(1.f + e); \
                        const bool earlier = (32 * (KT) + (i & 3) + 8 * (i >> 2) + 4 * h) < qi; \
                        ln[i] = earlier ? -sp : 0.f; z[i] = earlier ? (z[i] - sp) : -1e30f; sm += ln[i]; } \
                } \
                sm = xswap_add(sm); \
                f32x16 bt; _Pragma("unroll") for (int i = 0; i < 16; ++i) bt[i] = carry; \
                bt = MFMA32(tri[0], pack8<0>(ln), bt); bt = MFMA32(tri[1], pack8<1>(ln), bt); \
                _Pragma("unroll") for (int i = 0; i < 16; ++i) z[i] = __builtin_amdgcn_exp2f(z[i] + bt[i]); \
                P[2 * (KT)] = pack8<0>(z); P[2 * (KT) + 1] = pack8<1>(z); \
                carry += sm; tsum += sm; }
            SB_HALF(1)
            SB_HALF(0)
#undef SB_HALF
            R += tsum;
#pragma unroll
            for (int dt = 0; dt < 2; ++dt)
#pragma unroll
                for (int ks = 0; ks < 4; ++ks) { const s16x4 lo = trr(img + vaddr[0][dt] + 4096 * ks), hi = trr(img + vaddr[1][dt] + 4096 * ks);
                    o[dt] = MFMA32(cat8(lo, hi), P[ks], o[dt]); }
            done = __all(R < SB_THR) ? 1u : 0u;
        }
        if (lane == 0) flags[(cur << 3) + w] = done;
        if (t > 0) commit(t - 1, cur ^ 1);
        __syncthreads();
        bool alld = true;
#pragma unroll
        for (int k = 0; k < 8; ++k) alld = alld && (flags[(cur << 3) + k] != 0u);
        cur ^= 1;
        if (alld) break;
    }
    if (active) {
        bf16_t* orow = C.MIX + (size_t)qrow * DM + 512 + hh * 64;
#pragma unroll
        for (int dt = 0; dt < 2; ++dt)
#pragma unroll
            for (int g = 0; g < 4; ++g) { const int d = 32 * dt + 8 * g + 4 * h;
                u32x2 wv; wv.x = cvtpk(o[dt][4 * g], o[dt][4 * g + 1]); wv.y = cvtpk(o[dt][4 * g + 2], o[dt][4 * g + 3]);
                *(u32x2*)(orow + d) = wv; }
    }
    __syncthreads();
}
constexpr int N_DS = 64, N_DP = 512, N_SP = 512, N_SS = 128, N_UNITS = N_DS + N_DP + N_SP + N_SS;
}

#define XB_TMO      128
#define XB_XCNT(j)  (256  + 64 * (j))
#define XB_XSUB(j)  (1280 + 64 * (j))
#define XB_XGEN(j)  (2304 + 64 * (j))
#define XB_TOP      3328
#define XB_TOPGEN   3392
#define XCD_BAR_WORDS 3456
#define XB_SPIN_CAP (1u << 18)

__device__ __forceinline__ unsigned xb_ld(unsigned* p)              { return __hip_atomic_load(p, __ATOMIC_RELAXED, __HIP_MEMORY_SCOPE_AGENT); }
__device__ __forceinline__ unsigned xb_add(unsigned* p, unsigned v) { return __hip_atomic_fetch_add(p, v, __ATOMIC_RELAXED, __HIP_MEMORY_SCOPE_AGENT); }
__device__ __forceinline__ unsigned xb_xcc_id() { return (unsigned)__builtin_amdgcn_s_getreg((3 << 11) | 20) & 0xFu; }
#define XB_SPIN(cond, bar) do { unsigned _sp = 0; while (cond) { __builtin_amdgcn_s_sleep(1); \
    if ((++_sp & 255u) == 0u) { if (xb_ld(&(bar)[XB_TMO])) break; if (_sp > XB_SPIN_CAP) { atomicAdd(&(bar)[XB_TMO], 1u); break; } } } } while (0)

struct XcdBarrier {
    unsigned* bar; unsigned x;
    volatile LAS unsigned* st;
};

__device__ __forceinline__ XcdBarrier xcd_barrier_post(unsigned* bar, volatile LAS unsigned* st) {
    XcdBarrier b; b.bar = bar; b.x = xb_xcc_id(); b.st = st;
    if (threadIdx.x == 0) (void)xb_add(&bar[XB_XCNT(b.x)], 1u);
    return b;
}
__device__ __forceinline__ void xcd_barrier_complete(unsigned* bar, unsigned x, unsigned& nloc, unsigned& nx) {
    const unsigned G = gridDim.x * gridDim.y * gridDim.z;
    unsigned sum, cnt, mine, sp = 0u;
    for (;;) {
        sum = 0u; cnt = 0u; mine = 0u;
#pragma unroll
        for (unsigned j = 0; j < 16; ++j) { const unsigned c = xb_ld(&bar[XB_XCNT(j)]); sum += c; cnt += (c > 0u) ? 1u : 0u; mine = (j == x) ? c : mine; }
        if (sum == G) break;
        __builtin_amdgcn_s_sleep(1);
        if ((++sp & 255u) == 0u) { if (xb_ld(&bar[XB_TMO])) break; if (sp > XB_SPIN_CAP) { atomicAdd(&bar[XB_TMO], 1u); break; } }
    }
    nloc = mine > 0u ? mine : 1u; nx = cnt > 0u ? cnt : 1u;
}

__device__ __forceinline__ void xcd_barrier(const XcdBarrier& b) {
    asm volatile("s_waitcnt vmcnt(0)" ::: "memory");
    __syncthreads();
    if (threadIdx.x == 0) {
        unsigned* bar = b.bar;
        __builtin_amdgcn_s_waitcnt(0);
        unsigned nloc = b.st[0], nx = b.st[1];
        if (nloc == 0u) { xcd_barrier_complete(bar, b.x, nloc, nx); b.st[0] = nloc; b.st[1] = nx; }
        const unsigned old = xb_add(&bar[XB_XSUB(b.x)], 1u);
        const unsigned gen = old / nloc;
        if (old + 1u == (gen + 1u) * nloc) {
            __builtin_amdgcn_fence(__ATOMIC_RELEASE, "agent");
            asm volatile("s_waitcnt vmcnt(0)" ::: "memory");
            const unsigned og = xb_add(&bar[XB_TOP], 1u);
            const unsigned tg = og / nx;
            if (og + 1u == (tg + 1u) * nx) xb_add(&bar[XB_TOPGEN], 1u);
            else XB_SPIN(xb_ld(&bar[XB_TOPGEN]) == tg, bar);
            __builtin_amdgcn_fence(__ATOMIC_ACQUIRE, "agent");
            xb_add(&bar[XB_XGEN(b.x)], 1u);
            asm volatile("s_waitcnt vmcnt(0)" ::: "memory");
        } else {
            XB_SPIN(xb_ld(&bar[XB_XGEN(b.x)]) == gen, bar);
            __builtin_amdgcn_fence(__ATOMIC_ACQUIRE, "agent");
            asm volatile("s_waitcnt vmcnt(0)" ::: "memory");
        }
    }
    __syncthreads();
}

struct Params { const float* in[23]; float* out; unsigned char* ws; };

__global__ void __launch_bounds__(512, 2) fwd_megakernel(Params p) {
    extern __shared__ __attribute__((aligned(16))) unsigned char lds_raw[];
    cg::grid_group grid = cg::this_grid();
    LAS unsigned char* lds = (LAS unsigned char*)lds_raw;
    const int tid = threadIdx.x, lane = tid & 63, wave = __builtin_amdgcn_readfirstlane(tid >> 6);
    const int G = gridDim.x, NGW = G * 8, gw = wave * G + (int)blockIdx.x;
    unsigned char* ws = p.ws;
    unsigned* ctl = (unsigned*)(ws + WS_CTL);
    float* mod = (float*)(ws + WS_MOD);
    bf16_t* Win_t = (bf16_t*)(ws + WS_WIN); bf16_t* Wout_t = (bf16_t*)(ws + WS_WOUT); bf16_t* Wup_t = (bf16_t*)(ws + WS_WUP); bf16_t* Wdn_t = (bf16_t*)(ws + WS_WDN);
    bf16_t* XN = (bf16_t*)(ws + WS_XN); bf16_t* U = (bf16_t*)(ws + WS_U); bf16_t* MIX = (bf16_t*)(ws + WS_MIX); bf16_t* HB = (bf16_t*)(ws + WS_HB);
    float* Y = (float*)(ws + WS_Y); float* YP = (float*)(ws + WS_YP);
    const float* xp = p.in[0]; const float* xs = p.in[1];
    volatile LAS unsigned* bst = (volatile LAS unsigned*)(lds + LDS_MISC + 32);
    if (tid < 2) bst[tid] = 0u;
    __syncthreads();
    XcdBarrier bar = xcd_barrier_post(ctl + CW_BAR, bst);

    constexpr int rall = 0;
    {
        LAS float* scr = (LAS float*)(lds + wave * 16384);
        constexpr int I_MOD = NMOD / 32, I_IN = (DM / 64) * (NIN / 32), I_OUT = (DM / 64) * (DM / 32), I_UP = (DM / 64) * (DFF / 32), I_DN = (DFF / 64) * (DM / 32);
        constexpr int NITEMS = I_IN + I_OUT + I_UP + I_DN;
        for (int rep = 0; rep < REP_P0; ++rep) {
        for (int it = (int)blockIdx.x; it < I_MOD; it += G) p0_modulate_block(p.in[2], p.in[3], p.in[8], p.in[9], mod, lds, it, tid, lane, wave);
        for (int it = gw; it < NITEMS; it += NGW) {
            int r = it;
            if (r < I_IN) { p0_transpose_item(p.in[12], DM, NIN, Win_t, scr, r, lane); continue; } r -= I_IN;
            if (r < I_OUT) { p0_transpose_item(p.in[18], DM, DM, Wout_t, scr, r, lane); continue; } r -= I_OUT;
            if (r < I_UP) { p0_transpose_item(p.in[21], DM, DFF, Wup_t, scr, r, lane); continue; } r -= I_UP;
            p0_transpose_item(p.in[22], DFF, DM, Wdn_t, scr, r, lane);
        }
        }
    }
    if (p.ws == nullptr) grid.sync();
    xcd_barrier(bar);
    for (int rep = 0; rep < REP_SYNC; ++rep) xcd_barrier(bar);
    for (int rep = 0; rep < REP_ROW; ++rep)
    for (int row = gw; row < MT; row += NGW) {
        const float* xr = row < MP ? xp + (size_t)row * DM : xs + (size_t)(row - MP) * DM;
        p1_row(xr, mod, p.in[10], XN + (size_t)row * DM, row_bi(row), lane);
    }
    xcd_barrier(bar);
    {
        pg8::Gemm g{XN, Win_t, MT, NIN, DM}; pg8::StaticOrder S; S.init(MT, NIN, G, (int)blockIdx.x, DM);
        pg8::EpiQKV E{U, p.out};
        pg8::gemm_phase<pg8::EpiQKV, pg8::StaticOrder, true, true>(lds, g, S, E);
#if REP_GEMM > 1 || defined(REP_G1)
        __syncthreads(); pg8::gemm_phase<pg8::EpiQKV, pg8::StaticOrder, true, true>(lds, g, S, E);
#endif
    }
    xcd_barrier(bar);
#ifndef NO_ATT
    {
        att::Ctx C; C.U = U; C.MIX = MIX; C.cdk = p.in[4]; C.cdv = p.in[5]; C.csk = p.in[6]; C.csv = p.in[7]; C.subg = p.in[17];
        { const float a = p.in[13][lane] * p.in[14][lane], bq = p.in[15][lane] * p.in[16][lane];
          C.lam = __expf(wave_sum(a)) - __expf(wave_sum(bq)) + 0.2f; }
        LAS unsigned* qword = (LAS unsigned*)(lds + LDS_MISC);
        for (int rep = 0; rep < REP_ATT; ++rep)
        for (;;) {
            if (tid == 0) qword[0] = atomicAdd(ctl + rep + 4 * rall, 1u);
            __syncthreads();
            const int idx = (int)qword[0];
            __syncthreads();
            if (idx >= att::N_UNITS) break;
            bool is_diff, sample; int ub, uh, uu;
            if (idx < att::N_DS) { is_diff = true; sample = true; ub = idx >> 2; uh = idx & 3; uu = 0; }
            else if (idx < att::N_DS + att::N_DP) { const int j = idx - att::N_DS; is_diff = true; sample = false; ub = (j & 31) >> 2; uh = j & 3; uu = 15 - (j >> 5); }
            else if (idx < att::N_DS + att::N_DP + att::N_SP) { const int j = idx - att::N_DS - att::N_DP; is_diff = false; sample = false; ub = (j & 63) >> 3; uh = j & 7; uu = 7 - (j >> 6); }
            else { const int j = idx - att::N_DS - att::N_DP - att::N_SP; is_diff = false; sample = true; ub = j >> 3; uh = j & 7; uu = 0; }
#ifdef ATT_MASK
            if (rep > 0) { const int cls = is_diff ? (sample ? 1 : 2) : (sample ? 8 : 4); if (!(cls & ATT_MASK)) continue; }
#endif
            if (is_diff) att::diff_unit(C, (LAS char*)lds, sample, ub, uh, uu);
            else att::sb_unit(C, (LAS char*)lds, sample, ub, uh, uu);
        }
    }
#endif
    xcd_barrier(bar);
    {
        pg8::Gemm g{MIX, Wout_t, MT, DM, DM}; pg8::SplitOrder S; S.init(MP, MT, DM, G, (int)blockIdx.x, DM, NSPLIT_O);
        pg8::EpiF32 E{Y, DM, YP};
        pg8::gemm_phase<pg8::EpiF32, pg8::SplitOrder, true, true>(lds, g, S, E);
#if REP_GEMM > 1 || defined(REP_G2)
        __syncthreads(); pg8::gemm_phase<pg8::EpiF32, pg8::SplitOrder, true, true>(lds, g, S, E);
#endif
    }
    xcd_barrier(bar);
    for (int rep = 0; rep < REP_ROW; ++rep)
    for (int row = gw; row < MT; row += NGW) {
        const float* xr = row < MP ? xp + (size_t)row * DM : xs + (size_t)(row - MP) * DM;
        p5_row(xr, row < MP ? (const void*)(Y + (size_t)row * DM) : (const void*)(YP + (size_t)(row - MP) * DM), row < MP ? 1 : NSPLIT_O, mod, p.in[11], p.in[19], p.out + (size_t)row * DM, XN + (size_t)row * DM, row_bi(row), lane);
    }
    xcd_barrier(bar);
    {
        pg8::Gemm g{XN, Wup_t, MT, DFF, DM}; pg8::StaticOrder S; S.init(MT, DFF, G, (int)blockIdx.x, DM);
        pg8::EpiRelu2 E{HB, DFF};
        pg8::gemm_phase<pg8::EpiRelu2, pg8::StaticOrder, true, true>(lds, g, S, E);
#if REP_GEMM > 1 || defined(REP_G3)
        __syncthreads(); pg8::gemm_phase<pg8::EpiRelu2, pg8::StaticOrder, true, true>(lds, g, S, E);
#endif
    }
    xcd_barrier(bar);
    {
        pg8::Gemm g{HB, Wdn_t, MT, DM, DFF}; pg8::SplitOrder S; S.init(MP, MT, DM, G, (int)blockIdx.x, DFF, NSPLIT_D);
        pg8::EpiF32 E{Y, DM, YP};
        pg8::gemm_phase<pg8::EpiF32, pg8::SplitOrder, true, true>(lds, g, S, E);
#if REP_GEMM > 1 || defined(REP_G4)
        __syncthreads(); pg8::gemm_phase<pg8::EpiF32, pg8::SplitOrder, true, true>(lds, g, S, E);
#endif
    }
    xcd_barrier(bar);
    for (int row = gw; row < MT; row += NGW)
        p8_row(row < MP ? (const void*)(Y + (size_t)row * DM) : (const void*)(YP + (size_t)(row - MP) * DM), row < MP ? 1 : NSPLIT_D, mod, p.in[20], p.out + (size_t)row * DM, row_bi(row), lane);
}

extern "C" void kernel_launch(void* const* d_in, const int* in_sizes, int n_in, void* d_out, int out_size, void* d_ws, size_t ws_size, hipStream_t stream) {
    static int grid_blocks = 0;
    if (grid_blocks == 0) {
        if (n_in != 23 || ws_size < WS_END2) { fprintf(stderr, "kernel_launch: unexpected n_in %d / ws_size %zu\n", n_in, ws_size); grid_blocks = -1; return; }
        int dev = 0, cus = 0, per_cu = 0;
        hipGetDevice(&dev);
        hipDeviceGetAttribute(&cus, hipDeviceAttributeMultiprocessorCount, dev);
        hipFuncSetAttribute((const void*)fwd_megakernel, hipFuncAttributeMaxDynamicSharedMemorySize, LDS_BYTES);
        hipOccupancyMaxActiveBlocksPerMultiprocessor(&per_cu, (const void*)fwd_megakernel, 512, LDS_BYTES);
        (void)hipGetLastError();
        if (per_cu < 1) per_cu = 1;
        grid_blocks = cus * 1;
    }
    if (grid_blocks < 0) return;
    if (hipMemsetAsync((char*)d_ws + WS_CTL, 0, CTL_ZERO_BYTES, stream) != hipSuccess) { fprintf(stderr, "kernel_launch: memset failed\n"); return; }
    Params p{};
    for (int i = 0; i < 23; ++i) p.in[i] = (const float*)d_in[i];
    p.out = (float*)d_out; p.ws = (unsigned char*)d_ws;
    void* args[] = {&p};
    hipError_t e = hipLaunchCooperativeKernel((const void*)fwd_megakernel, dim3(grid_blocks), dim3(512), args, LDS_BYTES, stream);
    if (e != hipSuccess) fprintf(stderr, "cooperative launch failed: %s (grid %d)\n", hipGetErrorString(e), grid_blocks);
}
```

```cpp
#include <hip/hip_runtime.h>
#include <hip/hip_cooperative_groups.h>
#include <cstdio>
#include <cstdint>
namespace cg = cooperative_groups;
namespace pg8 {
#define PG8_LAS __attribute__((address_space(3)))
typedef unsigned short bf16_t;
typedef short bf16x8 __attribute__((ext_vector_type(8)));
typedef float f32x4 __attribute__((ext_vector_type(4)));
typedef unsigned u32x4 __attribute__((ext_vector_type(4)));
constexpr int BM = 256, BK = 64, HALF = 128, HTB = HALF * BK * 2  , STAGE_BYTES = 8 * HTB, NXCD = 8, WGM = 8;

__host__ __device__ __forceinline__ int lds_byte(int r, int c) { const int st = (r >> 4) * 2 + (c >> 5), rr = r & 15, cc = c & 31, ob = rr * 64 + cc * 2; return st * 1024 + (ob ^ (((ob >> 9) & 1) << 5)); }
__host__ __device__ __forceinline__ void stage_rc(int b, int& R, int& C) { const int st = b / 1024, sb = b % 1024, swz = sb ^ (((sb >> 9) & 1) << 5); R = (st >> 1) * 16 + swz / 64; C = (st & 1) * 32 + (swz % 64) / 2; }
__host__ __device__ __forceinline__ int perm32(int rho) { const int n = rho >> 4, i = rho & 15; return 8 * (i >> 2) + 4 * n + (i & 3); }

struct Unit { int pm, pn, k0, kn, ks; };
struct Gemm { const bf16_t* A; const bf16_t* Bt; int M, N, K; };

struct StaticOrder {
    int nM, nN, nwg, G, c, kt;
    __host__ __device__ void init(int M, int N, int G_, int c_, int K_) { nM = M / BM; nN = N / BM; nwg = nM * nN; G = G_; c = c_; kt = K_ / BK; }
    __host__ __device__ bool next(int i, Unit& u) const {
        const long L = (long)i * G + c; if (L >= nwg) return false;
        int wgid = (int)L; { const int q = nwg / NXCD, r = nwg % NXCD, xcd = wgid % NXCD, off = wgid / NXCD; wgid = (xcd < r ? xcd * (q + 1) : r * (q + 1) + (xcd - r) * q) + off; }
        const int nig = WGM * nN, gid = wgid / nig, fm = gid * WGM, gsz = (nM - fm) < WGM ? (nM - fm) : WGM;
        u.pm = fm + ((wgid % nig) % gsz); u.pn = (wgid % nig) / gsz; u.k0 = 0; u.kn = kt; u.ks = -1; return true;
    }
    __device__ __forceinline__ void a_ready(const Unit&) const {}
    __device__ __forceinline__ void done(const Unit&) const {}
};

struct SplitOrder {
    StaticOrder so; int pm0, nN, nsplit, kext, npieces, G, c;
    __host__ __device__ void init(int M0, int M, int N, int G_, int c_, int K_, int nsplit_) { so.init(M0, N, G_, c_, K_); pm0 = M0 / BM; nN = N / BM; nsplit = nsplit_; kext = K_ / nsplit_; npieces = ((M - M0) / BM) * nN * nsplit_; G = G_; c = c_; }
    __host__ __device__ bool next(int i, Unit& u) const {
        if (so.next(i, u)) return true;
        const int nmine = (so.nwg > c) ? (so.nwg - c + G - 1) / G : 0;
        const long L = (long)(i - nmine) * G + c; if (L >= npieces) return false;
        const int tile = (int)L / nsplit, ks = (int)L % nsplit;
        u.pm = pm0 + tile / nN; u.pn = tile % nN; u.k0 = ks * kext; u.kn = kext / BK; u.ks = ks; return true;
    }
    __device__ __forceinline__ void a_ready(const Unit&) const {}
    __device__ __forceinline__ void done(const Unit&) const {}
};

__device__ __forceinline__ unsigned cvt_pk_bf16(float lo, float hi) { unsigned r; asm volatile("v_cvt_pk_bf16_f32 %0, %1, %2" : "=v"(r) : "v"(lo), "v"(hi)); return r; }
typedef float f32x2 __attribute__((ext_vector_type(2)));
__device__ __forceinline__ f32x2 gelu_pk(f32x2 v) {
    const f32x2 av = __builtin_elementwise_abs(v), d = av * 0.2316418882f + 1.0f;
    f32x2 t; t.x = __builtin_amdgcn_rcpf(d.x); t.y = __builtin_amdgcn_rcpf(d.y);
    f32x2 q = t * 0.5307027145f + (-0.7265760135f); q = q * t + 0.7107068705f; q = q * t + (-0.142248368f); q = q * t + 0.127414796f; q = q * t;
    const f32x2 s = (v * v) * (-0.72134752044f);
    f32x2 e; e.x = __builtin_amdgcn_exp2f(s.x); e.y = __builtin_amdgcn_exp2f(s.y);
    const f32x2 m = v * (q * e), r = v - m;
    f32x2 o; o.x = v.x < 0.f ? m.x : r.x; o.y = v.y < 0.f ? m.y : r.y; return o;
}

template <int ACT  > struct EpiBf16 {
    static constexpr bool PERM = true, AFTER_DRAIN = false; static_assert(ACT == 0 || ACT == 1, "EpiBf16: ACT is 0 (none) or 1 (gelu_pk)");
    bf16_t* O; int ldc; const float* bias; int split_cols; size_t split_stride; float scale0;
    __device__ __forceinline__ void operator()(const f32x4 (&acc)[2][2][4][2], const Unit& u, int wr, int wc, int fr, int fq) const {
        const int row0 = u.pm * BM + wr * 64 + fr; int colt = u.pn * BM; bf16_t* base = O;
        float sc = 1.f; if (split_cols) { const int t = colt / split_cols; base += (size_t)t * split_stride; colt -= t * split_cols; if (t == 0) sc = scale0; }
        const int col0 = colt + wc * 32 + 8 * fq, bcol0 = u.pn * BM + wc * 32 + 8 * fq;
        f32x4 bv[2][2];
#pragma unroll
        for (int bj = 0; bj < 2; ++bj)
#pragma unroll
            for (int n = 0; n < 2; ++n) bv[bj][n] = bias ? *(const f32x4*)(bias + bcol0 + bj * HALF + 4 * n) : (f32x4){0.f, 0.f, 0.f, 0.f};
#pragma unroll
        for (int ai = 0; ai < 2; ++ai)
#pragma unroll
            for (int m = 0; m < 4; ++m) { bf16_t* rowp = base + (size_t)(row0 + ai * HALF + m * 16) * ldc + col0;
#pragma unroll
                for (int bj = 0; bj < 2; ++bj) { f32x4 v0 = acc[ai][bj][m][0] + bv[bj][0], v1 = acc[ai][bj][m][1] + bv[bj][1];
                    if (ACT == 1) { f32x2 a = gelu_pk((f32x2){v0[0], v0[1]}), b = gelu_pk((f32x2){v0[2], v0[3]}), c = gelu_pk((f32x2){v1[0], v1[1]}), d = gelu_pk((f32x2){v1[2], v1[3]});
                        v0 = (f32x4){a.x, a.y, b.x, b.y}; v1 = (f32x4){c.x, c.y, d.x, d.y}; }
                    v0 = v0 * sc; v1 = v1 * sc; u32x4 w; w.x = cvt_pk_bf16(v0[0], v0[1]); w.y = cvt_pk_bf16(v0[2], v0[3]); w.z = cvt_pk_bf16(v1[0], v1[1]); w.w = cvt_pk_bf16(v1[2], v1[3]);
                    *(u32x4*)(rowp + bj * HALF) = w; } }
    }
};

template <class Epi, class Sched, bool ALIGN_EPI = false, bool SP2 = false>
__device__ __forceinline__ void gemm_phase(PG8_LAS unsigned char* lds, const Gemm g, const Sched& S, const Epi& E) {
    int tid_ = threadIdx.x; asm volatile("" : "+v"(tid_));
    const int tid = tid_, wid = __builtin_amdgcn_readfirstlane(tid >> 6), lane = tid & 63, wr = wid >> 2, wc = wid & 3, fr = lane & 15, fq = lane >> 4;
    const int K = g.K;
    unsigned voffA[2], voffB[2];
#pragma unroll
    for (int i = 0; i < 2; ++i) { int R, C; stage_rc(tid * 16 + i * 8192, R, C); const int Rb = Epi::PERM ? ((R & ~31) + perm32(R & 31)) : R;
        voffA[i] = (unsigned)(R * K + C) * 2u; voffB[i] = (unsigned)(Rb * K + C) * 2u; }
    const size_t kstep = (size_t)(BK * 2);
    const size_t hstep = (size_t)HALF * K * 2;
    const size_t tstep = 2 * hstep;
    const unsigned ldsw = (unsigned)wid * 1024u;
    const int aoff = lds_byte(wr * 64 + fr, fq * 8), boff = lds_byte(wc * 32 + fr, fq * 8);
#define PG8_SA(b, h) (((b) * 2 + (h)) * HTB)
#define PG8_SB(b, h) ((4 + (b) * 2 + (h)) * HTB)
#define PG8_STAGE(bufoff, gbase, voff) do { _Pragma("unroll") for (int _i = 0; _i < 2; ++_i) \
        __builtin_amdgcn_global_load_lds((const unsigned*)((const char*)(gbase) + (voff)[_i]), (PG8_LAS unsigned*)(lds + (bufoff) + ldsw + _i * 8192), 16, 0, 0); } while (0)
#define PG8_LDA(dst, b, h) do { _Pragma("unroll") for (int m = 0; m < 4; ++m) _Pragma("unroll") for (int k = 0; k < 2; ++k) dst[m][k] = *(const PG8_LAS bf16x8*)(lds + PG8_SA(b, h) + aoff + m * 2048 + k * 1024); } while (0)
#define PG8_LDB(dst, b, h) do { _Pragma("unroll") for (int n = 0; n < 2; ++n) _Pragma("unroll") for (int k = 0; k < 2; ++k) dst[n][k] = *(const PG8_LAS bf16x8*)(lds + PG8_SB(b, h) + boff + n * 2048 + k * 1024); } while (0)
#define PG8_MMA(ai, bj, At, Bt) do { __builtin_amdgcn_s_setprio(1); _Pragma("unroll") for (int m = 0; m < 4; ++m) _Pragma("unroll") for (int n = 0; n < 2; ++n) _Pragma("unroll") for (int k = 0; k < 2; ++k) \
        acc[ai][bj][m][n] = __builtin_amdgcn_mfma_f32_16x16x32_bf16(Bt[n][k], At[m][k], acc[ai][bj][m][n], 0, 0, 0); __builtin_amdgcn_s_setprio(0); } while (0)
#define PG8_WAIT_V(n) asm volatile("s_waitcnt vmcnt(" #n ")" ::: "memory")
#define PG8_WAIT_L(n) asm volatile("s_waitcnt lgkmcnt(" #n ")" ::: "memory")
#define PG8_BAR __builtin_amdgcn_s_barrier()
#define PG8_SCHED __builtin_amdgcn_sched_barrier(0)
    Unit cur, nxt; int ui = 0;
    if (!S.next(0, cur)) return;
    f32x4 acc[2][2][4][2];
#pragma unroll
    for (int a = 0; a < 2; ++a)
#pragma unroll
        for (int b = 0; b < 2; ++b)
#pragma unroll
            for (int m = 0; m < 4; ++m)
#pragma unroll
                for (int n = 0; n < 2; ++n) acc[a][b][m][n] = (f32x4){0.f, 0.f, 0.f, 0.f};
    bf16x8 At[4][2], B0[2][2], B1[2][2];
    const char* cA = (const char*)g.A + (size_t)cur.pm * tstep + (size_t)cur.k0 * 2; const char* cB = (const char*)g.Bt + (size_t)cur.pn * tstep + (size_t)cur.k0 * 2;
    S.a_ready(cur);
    if constexpr (SP2) {
        PG8_STAGE(PG8_SB(0, 0), cB, voffB); PG8_STAGE(PG8_SB(0, 1), cB + hstep, voffB); PG8_STAGE(PG8_SA(0, 0), cA, voffA); PG8_STAGE(PG8_SA(0, 1), cA + hstep, voffA);
        if (wr == 1) PG8_BAR;
        PG8_WAIT_V(2); PG8_BAR;
        PG8_STAGE(PG8_SB(1, 0), cB + kstep, voffB); PG8_STAGE(PG8_SA(1, 0), cA + kstep, voffA); PG8_STAGE(PG8_SB(1, 1), cB + hstep + kstep, voffB);
        PG8_WAIT_V(6); PG8_BAR;
    } else {
        PG8_STAGE(PG8_SB(0, 0), cB, voffB); PG8_STAGE(PG8_SA(0, 0), cA, voffA); PG8_STAGE(PG8_SB(0, 1), cB + hstep, voffB); PG8_STAGE(PG8_SA(0, 1), cA + hstep, voffA);
        if (wr == 1) PG8_BAR;
        PG8_WAIT_V(4); PG8_BAR;
        PG8_STAGE(PG8_SB(1, 0), cB + kstep, voffB); PG8_STAGE(PG8_SA(1, 0), cA + kstep, voffA); PG8_STAGE(PG8_SB(1, 1), cB + hstep + kstep, voffB);
        PG8_WAIT_V(6); PG8_BAR;
    }
    for (;;) {
        const bool has_next = S.next(ui + 1, nxt);
        const char* nA = has_next ? (const char*)g.A + (size_t)nxt.pm * tstep + (size_t)nxt.k0 * 2 : cA; const char* nB = has_next ? (const char*)g.Bt + (size_t)nxt.pn * tstep + (size_t)nxt.k0 * 2 : cB;
        const int nt = cur.kn;
        for (int t = 0; t < nt; t += 2) {
            const bool last = (t == nt - 2);
            const char* a1 = cA + (size_t)(t + 1) * kstep;
            const char* a2 = last ? nA : cA + (size_t)(t + 2) * kstep; const char* b2 = last ? nB : cB + (size_t)(t + 2) * kstep;
            const char* a3 = a2 + kstep; const char* b3 = b2 + kstep;
            if (last && has_next) S.a_ready(nxt);
            if constexpr (SP2) {
            PG8_LDB(B0, 0, 0); PG8_LDB(B1, 0, 1); PG8_SCHED; PG8_LDA(At, 0, 0); PG8_STAGE(PG8_SA(1, 1), a1 + hstep, voffA);
            PG8_WAIT_V(8); PG8_WAIT_L(0); PG8_BAR; PG8_MMA(0, 0, At, B0); PG8_MMA(0, 1, At, B1); PG8_BAR; PG8_SCHED;
            PG8_LDA(At, 0, 1); PG8_STAGE(PG8_SB(0, 0), b2, voffB); PG8_STAGE(PG8_SB(0, 1), b2 + hstep, voffB); PG8_STAGE(PG8_SA(0, 0), a2, voffA);
            PG8_WAIT_V(8); PG8_WAIT_L(0); PG8_BAR; PG8_MMA(1, 0, At, B0); PG8_MMA(1, 1, At, B1); PG8_BAR; PG8_SCHED;
            PG8_LDB(B0, 1, 0); PG8_LDB(B1, 1, 1); PG8_SCHED; PG8_LDA(At, 1, 0); PG8_STAGE(PG8_SA(0, 1), a2 + hstep, voffA);
            PG8_WAIT_V(8); PG8_WAIT_L(0); PG8_BAR; PG8_MMA(0, 0, At, B0); PG8_MMA(0, 1, At, B1); PG8_BAR; PG8_SCHED;
            PG8_LDA(At, 1, 1); PG8_STAGE(PG8_SB(1, 0), b3, voffB); PG8_STAGE(PG8_SB(1, 1), b3 + hstep, voffB); PG8_STAGE(PG8_SA(1, 0), a3, voffA);
            PG8_WAIT_V(8); PG8_WAIT_L(0); PG8_BAR; PG8_MMA(1, 0, At, B0); PG8_MMA(1, 1, At, B1); PG8_BAR; PG8_SCHED;
            } else {
            PG8_LDB(B0, 0, 0); PG8_SCHED; PG8_LDA(At, 0, 0); PG8_STAGE(PG8_SA(1, 1), a1 + hstep, voffA);
            PG8_WAIT_L(8); PG8_BAR; PG8_WAIT_L(0); PG8_MMA(0, 0, At, B0); PG8_BAR; PG8_SCHED;
            PG8_LDB(B1, 0, 1); PG8_STAGE(PG8_SB(0, 0), b2, voffB);
            PG8_BAR; PG8_WAIT_L(0); PG8_MMA(0, 1, At, B1); PG8_BAR;
            PG8_LDA(At, 0, 1); PG8_STAGE(PG8_SA(0, 0), a2, voffA);
            PG8_BAR; PG8_WAIT_L(0); PG8_MMA(1, 0, At, B0); PG8_BAR; PG8_SCHED;
            PG8_STAGE(PG8_SB(0, 1), b2 + hstep, voffB);
            PG8_WAIT_V(6); PG8_BAR; PG8_MMA(1, 1, At, B1); PG8_BAR;
            PG8_LDB(B0, 1, 0); PG8_SCHED; PG8_LDA(At, 1, 0); PG8_STAGE(PG8_SA(0, 1), a2 + hstep, voffA);
            PG8_WAIT_L(8); PG8_BAR; PG8_WAIT_L(0); PG8_MMA(0, 0, At, B0); PG8_BAR; PG8_SCHED;
            PG8_LDB(B1, 1, 1); PG8_STAGE(PG8_SB(1, 0), b3, voffB);
            PG8_BAR; PG8_WAIT_L(0); PG8_MMA(0, 1, At, B1); PG8_BAR;
            PG8_LDA(At, 1, 1); PG8_STAGE(PG8_SA(1, 0), a3, voffA);
            PG8_BAR; PG8_WAIT_L(0); PG8_MMA(1, 0, At, B0); PG8_BAR; PG8_SCHED;
            PG8_STAGE(PG8_SB(1, 1), b3 + hstep, voffB);
            PG8_WAIT_V(6); PG8_BAR; PG8_MMA(1, 1, At, B1); PG8_BAR;
            }
        }
        if constexpr (ALIGN_EPI) { if (wr == 0) PG8_BAR; }
        if constexpr (!Epi::AFTER_DRAIN) { E(acc, cur, wr, wc, fr, fq); S.done(cur); }
        if (!has_next) break;
#pragma unroll
        for (int a = 0; a < 2; ++a)
#pragma unroll
            for (int b = 0; b < 2; ++b)
#pragma unroll
                for (int m = 0; m < 4; ++m)
#pragma unroll
                    for (int n = 0; n < 2; ++n) acc[a][b][m][n] = (f32x4){0.f, 0.f, 0.f, 0.f};
        cur = nxt; cA = nA; cB = nB; ++ui;
        if constexpr (ALIGN_EPI) { if (wr == 1) PG8_BAR; }
    }
    PG8_WAIT_V(0);
    if constexpr (!ALIGN_EPI) { if (wr == 0) PG8_BAR; }
    PG8_BAR;
    if constexpr (Epi::AFTER_DRAIN) { E.fused(acc, cur, wr, wc, fr, fq, lds, wid, lane); S.done(cur); }
#undef PG8_SA
#undef PG8_SB
#undef PG8_STAGE
#undef PG8_LDA
#undef PG8_LDB
#undef PG8_MMA
#undef PG8_WAIT_V
#undef PG8_WAIT_L
#undef PG8_BAR
#undef PG8_SCHED
}
}

#ifndef REP_ATT
#define REP_ATT 1
#endif
#ifndef REP_GEMM
#define REP_GEMM 1
#endif
#ifndef REP_ROW
#define REP_ROW 1
#endif
#ifndef REP_SYNC
#define REP_SYNC 0
#endif
#ifndef REP_ALL
#define REP_ALL 1
#endif
#ifndef REP_P0
#define REP_P0 1
#endif
constexpr int DM = 1024, NB = 8, SEQ = 2048, DB = 16, DSEQ = 64, PAST = 2048;
constexpr int MP = NB * SEQ, MS = DB * DSEQ, MT = MP + MS;
constexpr int NIN = 3072, DFF = 4096, NMOD = 6 * DM;
constexpr float EPS = 1e-6f;
constexpr float LOG2E = 1.4426950408889634f;
constexpr size_t O_KVP = (size_t)MT * DM;
constexpr size_t KVP_SZ = (size_t)MP * 512;
constexpr size_t O_KVS = O_KVP + 4 * KVP_SZ;
constexpr size_t KVS_SZ = (size_t)MS * 512;
constexpr size_t MiB = 1u << 20;
constexpr size_t WS_CTL = 0, WS_MOD = 1 * MiB, WS_WIN = 2 * MiB, WS_WOUT = 8 * MiB, WS_WUP = 10 * MiB, WS_WDN = 18 * MiB;
constexpr size_t WS_XN = 26 * MiB, WS_U = 60 * MiB, WS_MIX = 162 * MiB, WS_HB = 60 * MiB, WS_Y = 196 * MiB, WS_END = 264 * MiB;
static_assert(WS_XN + (size_t)MT * DM * 2 <= WS_U && WS_U + (size_t)MT * NIN * 2 <= WS_MIX && WS_MIX + (size_t)MT * DM * 2 <= WS_Y && WS_HB + (size_t)MT * DFF * 2 <= WS_Y && WS_Y + (size_t)MT * DM * 4 <= WS_END, "ws map");
constexpr size_t WS_YP = 264 * MiB, WS_END2 = 328 * MiB;
constexpr int NSPLIT_O = 8, NSPLIT_D = 16;
constexpr int LDS_BYTES = 131072 + 1024;
constexpr int LDS_MISC = 131072;
constexpr int CW_BAR = 4096;
constexpr size_t CTL_ZERO_BYTES = 65536;

#define LAS __attribute__((address_space(3)))
#define DI __device__ __forceinline__
typedef unsigned short bf16_t;
typedef short bf16x8 __attribute__((ext_vector_type(8)));
typedef short s16x4 __attribute__((ext_vector_type(4)));
typedef float f32x4 __attribute__((ext_vector_type(4)));
typedef float f32x16 __attribute__((ext_vector_type(16)));
typedef unsigned u32x4 __attribute__((ext_vector_type(4)));
typedef unsigned u32x2 __attribute__((ext_vector_type(2)));
typedef float f32x2_t __attribute__((ext_vector_type(2)));
typedef __bf16 bf16x2_t __attribute__((ext_vector_type(2)));
DI unsigned cvtpk(float lo, float hi) { f32x2_t v = {lo, hi}; bf16x2_t b = __builtin_convertvector(v, bf16x2_t); return __builtin_bit_cast(unsigned, b); }
#define LDS_WAIT() asm volatile("s_waitcnt lgkmcnt(0)" ::: "memory")

namespace pg8 {
struct EpiQKV {
    static constexpr bool PERM = true, AFTER_DRAIN = false;
    bf16_t* U; float* out;
    __device__ __forceinline__ void operator()(const f32x4 (&acc)[2][2][4][2], const Unit& u, int wr, int wc, int fr, int fq) const {
        const int sec = u.pn >> 1;
        const bool kv = (sec == 1) || (sec == 2) || (sec == 4) || (sec == 5);
        const int kvi = (sec == 1) ? 0 : (sec == 2) ? 1 : (sec == 4) ? 2 : 3;
        const bool prompt = u.pm < (MP / BM);
        const float qs = (sec == 0 || sec == 3) ? 0.125f * LOG2E : 1.f;
        float* fbase = prompt ? out + O_KVP + (size_t)kvi * KVP_SZ : out + O_KVS + (size_t)kvi * KVS_SZ - (size_t)MP * 512;
        const int row0 = u.pm * BM + wr * 64 + fr, col0 = u.pn * BM + wc * 32 + 8 * fq, colsec = col0 - sec * 512;
#pragma unroll
        for (int ai = 0; ai < 2; ++ai)
#pragma unroll
            for (int m = 0; m < 4; ++m) { const int row = row0 + ai * HALF + m * 16;
#pragma unroll
                for (int bj = 0; bj < 2; ++bj) { const f32x4 v0 = acc[ai][bj][m][0], v1 = acc[ai][bj][m][1];
                    const f32x4 s0 = v0 * qs, s1 = v1 * qs;
                    u32x4 w; w.x = cvt_pk_bf16(s0[0], s0[1]); w.y = cvt_pk_bf16(s0[2], s0[3]); w.z = cvt_pk_bf16(s1[0], s1[1]); w.w = cvt_pk_bf16(s1[2], s1[3]);
                    *(u32x4*)(U + (size_t)row * NIN + col0 + bj * HALF) = w;
                    if (kv) { float* d = fbase + (size_t)row * 512 + colsec + bj * HALF; *(f32x4*)d = v0; *(f32x4*)(d + 4) = v1; } } }
    }
};
struct EpiF32 {
    static constexpr bool PERM = true, AFTER_DRAIN = false;
    float* Y; int ldc; float* Ypart;
    __device__ __forceinline__ void operator()(const f32x4 (&acc)[2][2][4][2], const Unit& u, int wr, int wc, int fr, int fq) const {
        const int row0 = u.pm * BM + wr * 64 + fr, col0 = u.pn * BM + wc * 32 + 8 * fq;
        float* base = (u.ks < 0) ? Y : Ypart + ((size_t)u.ks * MS - MP) * (size_t)ldc;
#pragma unroll
        for (int ai = 0; ai < 2; ++ai)
#pragma unroll
            for (int m = 0; m < 4; ++m) { float* rowp = base + (size_t)(row0 + ai * HALF + m * 16) * ldc + col0;
#pragma unroll
                for (int bj = 0; bj < 2; ++bj) { *(f32x4*)(rowp + bj * HALF) = acc[ai][bj][m][0]; *(f32x4*)(rowp + bj * HALF + 4) = acc[ai][bj][m][1]; } }
    }
};
struct EpiRelu2 {
    static constexpr bool PERM = true, AFTER_DRAIN = false;
    bf16_t* O; int ldc;
    __device__ __forceinline__ void operator()(const f32x4 (&acc)[2][2][4][2], const Unit& u, int wr, int wc, int fr, int fq) const {
        const int row0 = u.pm * BM + wr * 64 + fr, col0 = u.pn * BM + wc * 32 + 8 * fq;
#pragma unroll
        for (int ai = 0; ai < 2; ++ai)
#pragma unroll
            for (int m = 0; m < 4; ++m) { bf16_t* rowp = O + (size_t)(row0 + ai * HALF + m * 16) * ldc + col0;
#pragma unroll
                for (int bj = 0; bj < 2; ++bj) { f32x4 v0 = acc[ai][bj][m][0], v1 = acc[ai][bj][m][1];
                    v0 = __builtin_elementwise_max(v0, (f32x4){0.f, 0.f, 0.f, 0.f}); v1 = __builtin_elementwise_max(v1, (f32x4){0.f, 0.f, 0.f, 0.f}); v0 = v0 * v0; v1 = v1 * v1;
                    u32x4 w; w.x = cvt_pk_bf16(v0[0], v0[1]); w.y = cvt_pk_bf16(v0[2], v0[3]); w.z = cvt_pk_bf16(v1[0], v1[1]); w.w = cvt_pk_bf16(v1[2], v1[3]);
                    *(u32x4*)(rowp + bj * HALF) = w; } }
    }
};
}

DI float wave_sum(float v) {
#pragma unroll
    for (int o = 1; o < 64; o <<= 1) v += __shfl_xor(v, o);
    return v;
}
DI unsigned f2bf(float f) { unsigned u = __builtin_bit_cast(unsigned, f); return (u + 0x7fffu + ((u >> 16) & 1u)) >> 16; }
DI unsigned pk2(float lo, float hi) { return f2bf(lo) | (f2bf(hi) << 16); }
DI float xswap_add(float v) { auto rr = __builtin_amdgcn_permlane32_swap(__float_as_uint(v), __float_as_uint(v), false, false); return __uint_as_float(rr[0]) + __uint_as_float(rr[1]); }
DI float xswap_max(float v) { auto rr = __builtin_amdgcn_permlane32_swap(__float_as_uint(v), __float_as_uint(v), false, false); return fmaxf(__uint_as_float(rr[0]), __uint_as_float(rr[1])); }

DI void p0_transpose_item(const float* W, int K, int N, bf16_t* WT, LAS float* scr, int item, int lane) {
    const int nblk = N / 32, kb = item / nblk, nb = item % nblk, k0 = 64 * kb, n0 = 32 * nb;
    float tv[32];
#pragma unroll
    for (int i = 0; i < 32; ++i) tv[i] = W[(size_t)(k0 + 2 * i + (lane >> 5)) * N + n0 + (lane & 31)];
#pragma unroll
    for (int i = 0; i < 32; ++i) scr[(2 * i + (lane >> 5)) * 33 + (lane & 31)] = tv[i];
    LDS_WAIT();
    const int c = lane & 7;
#pragma unroll
    for (int j = 0; j < 4; ++j) { const int n = (lane >> 3) + 8 * j; const LAS float* s = scr + (8 * c) * 33 + n;
        u32x4 o; o.x = pk2(s[0 * 33], s[1 * 33]); o.y = pk2(s[2 * 33], s[3 * 33]); o.z = pk2(s[4 * 33], s[5 * 33]); o.w = pk2(s[6 * 33], s[7 * 33]);
        *(u32x4*)(WT + (size_t)(n0 + n) * K + k0 + 8 * c) = o; }
    LDS_WAIT();
}
DI void p0_modulate_block(const float* cp, const float* cs, const float* w_ada, const float* b_ada, float* mod, LAS unsigned char* lds, int item, int tid, int lane, int wave) {
    LAS float* scr = (LAS float*)(lds + wave * 16384);
    LAS float* red = (LAS float*)(lds + wave * 16384 + 12288);
#pragma unroll 8
    for (int e = lane; e < 24 * 128; e += 64) { const int bi = e >> 7, j = e & 127;
        const float v = (bi < 8) ? cp[bi * DM + 128 * wave + j] : cs[(bi - 8) * DM + 128 * wave + j];
        scr[e] = v / (1.f + __expf(-v)); }
    LDS_WAIT();
    const int kh = lane >> 5;
    const float* wp = w_ada + (size_t)(128 * wave + 64 * kh) * NMOD + item * 32 + (lane & 31);
    float acc[24];
#pragma unroll
    for (int bi = 0; bi < 24; ++bi) acc[bi] = 0.f;
#pragma unroll 4
    for (int j4 = 0; j4 < 16; ++j4) {
        float wv[4];
#pragma unroll
        for (int q = 0; q < 4; ++q) wv[q] = wp[(size_t)(4 * j4 + q) * NMOD];
#pragma unroll
        for (int bi = 0; bi < 24; ++bi) { const f32x4 sv = *(const LAS f32x4*)(scr + bi * 128 + 64 * kh + 4 * j4); acc[bi] += (sv.x * wv[0] + sv.y * wv[1]) + (sv.z * wv[2] + sv.w * wv[3]); }
    }
#pragma unroll
    for (int bi = 0; bi < 24; ++bi) acc[bi] += __shfl_xor(acc[bi], 32);
    if (lane < 32) {
#pragma unroll
        for (int bi = 0; bi < 24; ++bi) red[bi * 32 + lane] = acc[bi]; }
    __syncthreads();
    for (int e = tid; e < 24 * 32; e += 512) { float sum = 0.f;
#pragma unroll
        for (int w8 = 0; w8 < 8; ++w8) sum += ((const LAS float*)(lds + w8 * 16384 + 12288))[e];
        const int c = item * 32 + (e & 31); mod[(e >> 5) * NMOD + c] = sum + b_ada[c]; }
    __syncthreads();
}

DI int row_bi(int row) { return row < MP ? (row >> 11) : 8 + ((row - MP) >> 6); }
DI void p1_row(const float* xrow, const float* mod, const float* g, bf16_t* orow, int bi, int lane) {
    const f32x4* xr = (const f32x4*)xrow + lane; f32x4 v[4]; float s = 0.f;
#pragma unroll
    for (int j = 0; j < 4; ++j) { v[j] = xr[64 * j]; s += (v[j].x * v[j].x + v[j].y * v[j].y) + (v[j].z * v[j].z + v[j].w * v[j].w); }
    const float r = rsqrtf(wave_sum(s) * (1.f / DM) + EPS);
    const f32x4* gg = (const f32x4*)g + lane; const f32x4* sh = (const f32x4*)(mod + (size_t)bi * NMOD) + lane; const f32x4* sc = (const f32x4*)(mod + (size_t)bi * NMOD + DM) + lane;
    u32x2* o8 = (u32x2*)orow + lane;
#pragma unroll
    for (int j = 0; j < 4; ++j) { const f32x4 h = v[j] * r * gg[64 * j] * (sc[64 * j] + 1.f) + sh[64 * j]; u32x2 w; w.x = cvtpk(h.x, h.y); w.y = cvtpk(h.z, h.w); o8[64 * j] = w; }
}
DI f32x4 load_y(const void* yrow, int nsum, int lane, int j) {
    const f32x4* yr = (const f32x4*)yrow + lane + 64 * j; f32x4 y = yr[0];
    for (int k = 1; k < nsum; ++k) y = y + yr[(size_t)k * (MS * DM / 4)];
    return y;
}
DI void p5_row(const float* xrow, const void* yrow, int nsum, const float* mod, const float* gpost, const float* gpre2, float* outrow, bf16_t* xnrow, int bi, int lane) {
    const f32x4* xr = (const f32x4*)xrow + lane; f32x4 y[4], x1[4]; float s = 0.f;
#pragma unroll
    for (int j = 0; j < 4; ++j) { y[j] = load_y(yrow, nsum, lane, j);
        s += (y[j].x * y[j].x + y[j].y * y[j].y) + (y[j].z * y[j].z + y[j].w * y[j].w); }
    const float r1 = rsqrtf(wave_sum(s) * (1.f / DM) + EPS);
    const float* mb = mod + (size_t)bi * NMOD;
    const f32x4* gp = (const f32x4*)gpost + lane; const f32x4* ga = (const f32x4*)(mb + 2 * DM) + lane;
    float s2 = 0.f; f32x4* orow = (f32x4*)outrow + lane;
#pragma unroll
    for (int j = 0; j < 4; ++j) { x1[j] = xr[64 * j] + ga[64 * j] * (y[j] * r1 * gp[64 * j]); orow[64 * j] = x1[j];
        s2 += (x1[j].x * x1[j].x + x1[j].y * x1[j].y) + (x1[j].z * x1[j].z + x1[j].w * x1[j].w); }
    const float r2 = rsqrtf(wave_sum(s2) * (1.f / DM) + EPS);
    const f32x4* g2 = (const f32x4*)gpre2 + lane; const f32x4* sh = (const f32x4*)(mb + 3 * DM) + lane; const f32x4* sc = (const f32x4*)(mb + 4 * DM) + lane;
    u32x2* o8 = (u32x2*)xnrow + lane;
#pragma unroll
    for (int j = 0; j < 4; ++j) { const f32x4 h = x1[j] * r2 * g2[64 * j] * (sc[64 * j] + 1.f) + sh[64 * j]; u32x2 w; w.x = cvtpk(h.x, h.y); w.y = cvtpk(h.z, h.w); o8[64 * j] = w; }
}
DI void p8_row(const void* yrow, int nsum, const float* mod, const float* gpost, float* outrow, int bi, int lane) {
    f32x4 y[4]; float s = 0.f;
#pragma unroll
    for (int j = 0; j < 4; ++j) { y[j] = load_y(yrow, nsum, lane, j);
        s += (y[j].x * y[j].x + y[j].y * y[j].y) + (y[j].z * y[j].z + y[j].w * y[j].w); }
    const float r1 = rsqrtf(wave_sum(s) * (1.f / DM) + EPS);
    const f32x4* gp = (const f32x4*)gpost + lane; const f32x4* ga = (const f32x4*)(mod + (size_t)bi * NMOD + 5 * DM) + lane; f32x4* orow = (f32x4*)outrow + lane;
#pragma unroll
    for (int j = 0; j < 4; ++j) orow[64 * j] = orow[64 * j] + ga[64 * j] * (y[j] * r1 * gp[64 * j]);
}

namespace att {
#define MFMA32(a, b, c) __builtin_amdgcn_mfma_f32_32x32x16_bf16((a), (b), (c), 0, 0, 0)
typedef short v4i16_t __attribute__((ext_vector_type(4)));
DI unsigned off_b(unsigned row, unsigned ch) { return 256u * row + 16u * (ch ^ (((row & 3u) << 2) | ((row >> 2) & 3u))); }
DI s16x4 trr(const LAS char* p) { return __builtin_bit_cast(s16x4, __builtin_amdgcn_ds_read_tr16_b64_v4i16((LAS v4i16_t*)p)); }
DI bf16x8 cat8(s16x4 lo, s16x4 hi) { return (bf16x8){lo[0], lo[1], lo[2], lo[3], hi[0], hi[1], hi[2], hi[3]}; }
template <int S> DI bf16x8 pack8(const f32x16& x) { u32x4 p; p[0] = cvtpk(x[8 * S], x[8 * S + 1]); p[1] = cvtpk(x[8 * S + 2], x[8 * S + 3]); p[2] = cvtpk(x[8 * S + 4], x[8 * S + 5]); p[3] = cvtpk(x[8 * S + 6], x[8 * S + 7]); return __builtin_bit_cast(bf16x8, p); }
DI u32x4 cvt8(u32x4 a, u32x4 b) {
    u32x4 o; o.x = cvtpk(__uint_as_float(a.x), __uint_as_float(a.y)); o.y = cvtpk(__uint_as_float(a.z), __uint_as_float(a.w));
    o.z = cvtpk(__uint_as_float(b.x), __uint_as_float(b.y)); o.w = cvtpk(__uint_as_float(b.z), __uint_as_float(b.w)); return o; }

DI void dma16(const void* g, LAS char* l) { __builtin_amdgcn_global_load_lds((const unsigned*)g, (LAS unsigned*)l, 16, 0, 0); }
#define ATT_WAITV(n) asm volatile("s_waitcnt vmcnt(" #n ")" ::: "memory")
#define ATT_BAR() do { asm volatile("s_waitcnt lgkmcnt(0)" ::: "memory"); __builtin_amdgcn_s_barrier(); asm volatile("" ::: "memory"); } while (0)
struct Ctx {
    const bf16_t* U; bf16_t* MIX;
    const float *cdk, *cdv, *csk, *csv;
    const float* subg; float lam;
};

DI void diff_unit(const Ctx& C, LAS char* lds, bool sample, int b, int hh, int u) {
    int tid_ = threadIdx.x; asm volatile("" : "+v"(tid_));
    const int tid = tid_, lane = tid & 63, r = lane & 31, h = lane >> 5, w = __builtin_amdgcn_readfirstlane(tid >> 6);
    const int qblk = w >> 1, map = w & 1;
    const bool active = sample ? (w < 4) : true;
    const int ncache = sample ? 32 : 0;
    const int tokbase = sample ? MP + b * DSEQ : b * SEQ;
    const int cbase = b * PAST;
    const int Tmax = sample ? 32 : 2 * u + 1;
    const int qrel = sample ? 32 * qblk : 128 * u + 32 * qblk;
    const int Tw = sample ? 32 : (qrel >> 6);
    const int qpos = (sample ? PAST : 0) + qrel + r;
    const int qrow = tokbase + (active ? qrel : 0) + r;
    bf16x8 qf[4];
#pragma unroll
    for (int ds = 0; ds < 4; ++ds) qf[ds] = *(const bf16x8*)(C.U + (size_t)qrow * NIN + hh * 128 + map * 64 + 16 * ds + 8 * h);
    unsigned kaddr[4];
    { const unsigned x = ((r & 3u) << 2) | ((r >> 2) & 3u);
#pragma unroll
      for (int ds = 0; ds < 4; ++ds) kaddr[ds] = 256u * r + 16u * ((unsigned)(2 * (4 * map + ds) + h) ^ x); }
    unsigned vaddr[4];
    { const unsigned blk = (lane >> 4) & 1, q = (lane & 15) >> 2, p = lane & 3;
#pragma unroll
      for (int c = 0; c < 4; ++c) vaddr[c] = off_b(4 * h + q, 4 * c + 2 * blk + (p >> 1)) + 8 * (p & 1); }
    const int srow = tid >> 4, sch = tid & 15;
    const unsigned sdst0 = off_b(srow, sch), sdst1 = off_b(srow + 32, sch);
    u32x4 st[4];
    auto issue_bf = [&](int t) {
        const bf16_t* g0 = C.U + (size_t)(tokbase + 64 * (t - ncache) + srow) * NIN + hh * 128 + sch * 8 + 512; const bf16_t* g1 = g0 + (size_t)32 * NIN;
        st[0] = *(const u32x4*)g0; st[1] = *(const u32x4*)g1; st[2] = *(const u32x4*)(g0 + 512); st[3] = *(const u32x4*)(g1 + 512);
    };
    auto commit_bf = [&](int buf) {
        LAS char* kimg = lds + buf * 32768; LAS char* vimg = kimg + 16384;
        *(LAS u32x4*)(kimg + sdst0) = st[0]; *(LAS u32x4*)(kimg + sdst1) = st[1]; *(LAS u32x4*)(vimg + sdst0) = st[2]; *(LAS u32x4*)(vimg + sdst1) = st[3];
    };
    auto issue_f32 = [&](int t, int isv) {
        const float* src = isv ? C.cdv : C.cdk;
        const size_t o0 = (size_t)(cbase + 64 * t + srow) * 512 + hh * 128 + sch * 8, o1 = o0 + (size_t)32 * 512;
        st[0] = *(const u32x4*)(src + o0); st[1] = *(const u32x4*)(src + o0 + 4); st[2] = *(const u32x4*)(src + o1); st[3] = *(const u32x4*)(src + o1 + 4);
    };
    auto commit_f32 = [&](int buf, int isv) {
        LAS char* img = lds + buf * 32768 + (isv ? 16384 : 0);
        *(LAS u32x4*)(img + sdst0) = cvt8(st[0], st[1]); *(LAS u32x4*)(img + sdst1) = cvt8(st[2], st[3]);
    };
    const float slope = __builtin_amdgcn_exp2f(-2.f * (float)(hh + 1));
    const float sl2 = slope * LOG2E;
    f32x16 o[4];
#pragma unroll
    for (int dt = 0; dt < 4; ++dt)
#pragma unroll
        for (int i = 0; i < 16; ++i) o[dt][i] = 0.f;
    float mrun = 0.f, lrun = 0.f;

    bf16x8 P[4];
    auto qk_part = [&](int t, const LAS char* kimg) {
            const bool diag = (t == Tw);
            f32x16 s0, s1;
            const float kb0 = sl2 * (float)(64 * t + 4 * h) - mrun;
            if (!diag) {
#pragma unroll
                for (int i = 0; i < 16; ++i) { const float ci = (float)((i & 3) + 8 * (i >> 2)); s0[i] = __builtin_fmaf(sl2, ci, kb0); s1[i] = __builtin_fmaf(sl2, ci + 32.f, kb0); }
            } else {
                float dq = (float)(qpos - 64 * t - 4 * h); asm volatile("" : "+v"(dq));
                const float m2 = -2.f * sl2;
#pragma unroll
                for (int i = 0; i < 16; ++i) { const float ci = (float)((i & 3) + 8 * (i >> 2));
                    s0[i] = __builtin_fmaf(m2, fmaxf(ci - dq, 0.f), __builtin_fmaf(sl2, ci, kb0)); s1[i] = __builtin_fmaf(m2, fmaxf(ci + 32.f - dq, 0.f), __builtin_fmaf(sl2, ci + 32.f, kb0)); }
            }
#pragma unroll
            for (int ds = 0; ds < 4; ++ds) {
                const bf16x8 k0 = *(const LAS bf16x8*)(kimg + kaddr[ds]); const bf16x8 k1 = *(const LAS bf16x8*)(kimg + kaddr[ds] + 8192);
                s0 = MFMA32(k0, qf[ds], s0); s1 = MFMA32(k1, qf[ds], s1); }
            float mx = fmaxf(s0[0], s1[0]);
#pragma unroll
            for (int i = 1; i < 16; ++i) mx = fmaxf(mx, fmaxf(s0[i], s1[i]));
            mx = xswap_max(mx);
            if (diag || __any(mx > 0.f)) {
                const float dl = diag ? mx : fmaxf(mx, 0.f), alpha = diag ? 0.f : __builtin_amdgcn_exp2f(-dl); mrun += dl; lrun *= alpha;
#pragma unroll
                for (int i = 0; i < 16; ++i) { s0[i] -= dl; s1[i] -= dl; }
#pragma unroll
                for (int dt = 0; dt < 4; ++dt)
#pragma unroll
                    for (int i = 0; i < 16; ++i) o[dt][i] *= alpha; }
            float ps = 0.f;
#pragma unroll
            for (int i = 0; i < 16; ++i) { s0[i] = __builtin_amdgcn_exp2f(s0[i]); s1[i] = __builtin_amdgcn_exp2f(s1[i]); ps += s0[i] + s1[i]; }
            lrun += ps;
            P[0] = pack8<0>(s0); P[1] = pack8<1>(s0); P[2] = pack8<0>(s1); P[3] = pack8<1>(s1);
    };
    auto pv_part = [&](const LAS char* vimg) {
#pragma unroll
            for (int dt = 0; dt < 4; ++dt)
#pragma unroll
                for (int ks = 0; ks < 4; ++ks) { const s16x4 lo = trr(vimg + vaddr[dt] + 4096 * ks), hi = trr(vimg + (vaddr[dt] ^ 32u) + 2048 + 4096 * ks);
                    o[dt] = MFMA32(cat8(lo, hi), P[ks], o[dt]); }
    };
    if (sample) {
        issue_bf(Tmax); commit_bf(0);
        __syncthreads();
        int cur = 0;
        for (int t = Tmax; t >= 0; --t) {
            const bool comp = active && t <= Tw;
            const LAS char* kimg = lds + cur * 32768; const LAS char* vimg = kimg + 16384;
            if (t > 0) issue_f32(t - 1, 0);
            if (comp) qk_part(t, kimg);
            if (t > 0) { commit_f32(cur ^ 1, 0); issue_f32(t - 1, 1); }
            if (comp) pv_part(vimg);
            if (t > 0) commit_f32(cur ^ 1, 1);
            __syncthreads();
            cur ^= 1;
        }
    } else {
        const int drow = 4 * w + (lane >> 4); const unsigned dch = (unsigned)(lane & 15) ^ ((((unsigned)drow & 3u) << 2) | (((unsigned)drow >> 2) & 3u));
        const char* gsrc = (const char*)(C.U + (size_t)(tokbase + drow) * NIN + 512 + hh * 128 + dch * 8);
        auto dma_tile = [&](int t) { const char* tb = gsrc + (size_t)t * (64 * NIN * 2); LAS char* sd = lds + (t & 3) * 32768 + w * 1024;
            dma16(tb, sd); dma16(tb + 32 * NIN * 2, sd + 8192); dma16(tb + 1024, sd + 16384); dma16(tb + 1024 + 32 * NIN * 2, sd + 16384 + 8192); };
        dma_tile(Tmax); if (Tmax >= 1) dma_tile(Tmax - 1); if (Tmax >= 2) dma_tile(Tmax - 2);
        for (int t = Tmax; t >= 0; --t) {
            if (t >= 2) ATT_WAITV(8); else if (t == 1) ATT_WAITV(4); else ATT_WAITV(0);
            ATT_BAR();
            if (t >= 3) dma_tile(t - 3);
            if (t <= Tw) { const LAS char* kimg = lds + (t & 3) * 32768; qk_part(t, kimg); pv_part(kimg + 16384); }
        }
        ATT_BAR();
    }
    const float inv = 1.f / xswap_add(lrun);
    LAS float* X = (LAS float*)(lds + (w >> 1) * 16384);
    if (active && map == 1) { const float f = C.lam * inv;
#pragma unroll
        for (int dt = 0; dt < 4; ++dt)
#pragma unroll
            for (int i = 0; i < 16; ++i) X[(dt * 16 + i) * 64 + lane] = o[dt][i] * f; }
    __syncthreads();
    if (active && map == 0) { float ss = 0.f;
#pragma unroll
        for (int dt = 0; dt < 4; ++dt)
#pragma unroll
            for (int i = 0; i < 16; ++i) { const float v = o[dt][i] * inv - X[(dt * 16 + i) * 64 + lane]; o[dt][i] = v; ss += v * v; }
        ss = xswap_add(ss);
        const float rn = rsqrtf(ss * (1.f / 128.f) + EPS) * 0.8f;
        bf16_t* orow = C.MIX + (size_t)qrow * DM + hh * 128;
#pragma unroll
        for (int dt = 0; dt < 4; ++dt)
#pragma unroll
            for (int g = 0; g < 4; ++g) { const int d = 32 * dt + 8 * g + 4 * h; const f32x4 gg = *(const f32x4*)(C.subg + d);
                u32x2 wv; wv.x = cvtpk(o[dt][4 * g] * rn * gg.x, o[dt][4 * g + 1] * rn * gg.y); wv.y = cvtpk(o[dt][4 * g + 2] * rn * gg.z, o[dt][4 * g + 3] * rn * gg.w);
                *(u32x2*)(orow + d) = wv; } }
    __syncthreads();
}

constexpr float SB_THR = -150.f;
DI void sb_unit(const Ctx& C, LAS char* lds, bool sample, int b, int hh, int qb) {
    int tid_ = threadIdx.x; asm volatile("" : "+v"(tid_));
    const int tid = tid_, lane = tid & 63, r = lane & 31, h = lane >> 5, w = __builtin_amdgcn_readfirstlane(tid >> 6);
    const bool active = sample ? (w < 2) : true;
    const int ncache = sample ? 32 : 0;
    const int tokbase = sample ? MP + b * DSEQ : b * SEQ;
    const int cbase = b * PAST;
    const int Tmax = sample ? 32 : 4 * qb + 3;
    const int qrel = sample ? 32 * w : 256 * qb + 32 * w;
    const int Tw = sample ? 32 : (qrel >> 6);
    const int qi = (qrel & 63) + r;
    const int qrow = tokbase + (active ? qrel : 0) + r;
    LAS unsigned* flags = (LAS unsigned*)(lds + 65536);
    bf16x8 qf[4];
#pragma unroll
    for (int ds = 0; ds < 4; ++ds) qf[ds] = *(const bf16x8*)(C.U + (size_t)qrow * NIN + 1536 + hh * 64 + 16 * ds + 8 * h);
    unsigned kaddr[4];
    { const unsigned x = ((r & 3u) << 2) | ((r >> 2) & 3u);
#pragma unroll
      for (int ds = 0; ds < 4; ++ds) kaddr[ds] = 256u * r + 16u * ((unsigned)(2 * ds + h) ^ x); }
    unsigned vaddr[2];
    { const unsigned blk = (lane >> 4) & 1, q = (lane & 15) >> 2, p = lane & 3;
#pragma unroll
      for (int c = 0; c < 2; ++c) vaddr[c] = off_b(4 * h + q, 4 * (c + 2) + 2 * blk + (p >> 1)) + 8 * (p & 1); }
    bf16x8 tri[2];
#pragma unroll
    for (int s = 0; s < 2; ++s)
#pragma unroll
        for (int j = 0; j < 8; ++j) tri[s][j] = ((16 * s + 8 * (j >> 2) + 4 * h + (j & 3)) > r) ? (short)0x3F80 : (short)0;
    const int srow = tid >> 4, sch = tid & 15;
    const unsigned sdst0 = off_b(srow, sch), sdst1 = off_b(srow + 32, sch);
    const int scol = (sch < 8) ? (2048 + hh * 64 + sch * 8) : (2560 + hh * 64 + (sch - 8) * 8);
    const float* csrc = (sch < 8) ? C.csk : C.csv;
    u32x4 st[4];
    auto issue = [&](int t) {
        if (t < ncache) {
            const size_t o0 = (size_t)(cbase + 64 * t + srow) * 512 + hh * 64 + (sch & 7) * 8, o1 = o0 + (size_t)32 * 512;
            st[0] = *(const u32x4*)(csrc + o0); st[1] = *(const u32x4*)(csrc + o0 + 4); st[2] = *(const u32x4*)(csrc + o1); st[3] = *(const u32x4*)(csrc + o1 + 4);
        } else {
            const bf16_t* g0 = C.U + (size_t)(tokbase + 64 * (t - ncache) + srow) * NIN + scol;
            st[0] = *(const u32x4*)g0; st[1] = *(const u32x4*)(g0 + (size_t)32 * NIN);
        }
    };
    auto commit = [&](int t, int buf) {
        LAS char* img = lds + buf * 16384;
        if (t < ncache) { *(LAS u32x4*)(img + sdst0) = cvt8(st[0], st[1]); *(LAS u32x4*)(img + sdst1) = cvt8(st[2], st[3]); }
        else { *(LAS u32x4*)(img + sdst0) = st[0]; *(LAS u32x4*)(img + sdst1) = st[1]; }
    };
    f32x16 o[2];
#pragma unroll
    for (int dt = 0; dt < 2; ++dt)
#pragma unroll
        for (int i = 0; i < 16; ++i) o[dt][i] = 0.f;
    float R = 0.f;

    auto tile_part = [&](int t, const LAS char* img) {
            const bool diag = (t == Tw);
            bf16x8 P[4];
            float carry = R;
            float tsum = 0.f;
#define SB_HALF(KT) { \
                f32x16 z; _Pragma("unroll") for (int i = 0; i < 16; ++i) z[i] = 0.f; \
                _Pragma("unroll") for (int ds = 0; ds < 4; ++ds) { const bf16x8 kf = *(const LAS bf16x8*)(img + kaddr[ds] + 8192 * (KT)); z = MFMA32(kf, qf[ds], z); } \
                f32x16 ln; float sm = 0.f; \
                if (!diag) { \
                    _Pragma("unroll") for (int i = 0; i < 16; ++i) { const float e = __builtin_amdgcn_exp2f(-fabsf(z[i])); \
                        const float sp = fmaxf(z[i], 0.f) + __builtin_amdgcn_logf(1.f + e); ln[i] = -sp; z[i] -= sp; sm -= sp; } \
                } else { \
                    _Pragma("unroll") for (int i = 0; i < 16; ++i) { const float e = __builtin_amdgcn_exp2f(-fabsf(z[i])); \
                        const float sp = fmaxf(z[i], 0.f) + __builtin_amdgcn_logf(1.f + e); \
                        const bool earlier = (32 * (KT) + (i & 3) + 8 * (i >> 2) + 4 * h) < qi; \
                        ln[i] = earlier ? -sp : 0.f; z[i] = earlier ? (z[i] - sp) : -1e30f; sm += ln[i]; } \
                } \
                sm = xswap_add(sm); \
                f32x16 bt; _Pragma("unroll") for (int i = 0; i < 16; ++i) bt[i] = carry; \
                bt = MFMA32(tri[0], pack8<0>(ln), bt); bt = MFMA32(tri[1], pack8<1>(ln), bt); \
                _Pragma("unroll") for (int i = 0; i < 16; ++i) z[i] = __builtin_amdgcn_exp2f(z[i] + bt[i]); \
                P[2 * (KT)] = pack8<0>(z); P[2 * (KT) + 1] = pack8<1>(z); \
                carry += sm; tsum += sm; }
            SB_HALF(1)
            SB_HALF(0)
#undef SB_HALF
            R += tsum;
#pragma unroll
            for (int dt = 0; dt < 2; ++dt)
#pragma unroll
                for (int ks = 0; ks < 4; ++ks) { const s16x4 lo = trr(img + vaddr[dt] + 4096 * ks), hi = trr(img + (vaddr[dt] ^ 32u) + 2048 + 4096 * ks);
                    o[dt] = MFMA32(cat8(lo, hi), P[ks], o[dt]); }
    };
    if (sample) {
        issue(Tmax); commit(Tmax, 0); __syncthreads();
        int cur = 0;
        for (int t = Tmax; t >= 0; --t) {
            if (t > 0) issue(t - 1);
            unsigned done = active ? 0u : 1u;
            if (active && t <= Tw) { tile_part(t, lds + cur * 16384); done = __all(R < SB_THR) ? 1u : 0u; }
            if (lane == 0) flags[(cur << 3) + w] = done;
            if (t > 0) commit(t - 1, cur ^ 1);
            __syncthreads();
            bool alld = true;
#pragma unroll
            for (int k = 0; k < 8; ++k) alld = alld && (flags[(cur << 3) + k] != 0u);
            cur ^= 1;
            if (alld) break;
        }
    } else {
        const int drow = 4 * w + (lane >> 4); const unsigned dch = (unsigned)(lane & 15) ^ ((((unsigned)drow & 3u) << 2) | (((unsigned)drow >> 2) & 3u));
        const char* gsrc = (const char*)(C.U + (size_t)(tokbase + drow) * NIN + ((dch < 8) ? (2048 + hh * 64 + dch * 8) : (2560 + hh * 64 + (dch - 8) * 8)));
        auto dma_tile = [&](int t) { const char* tb = gsrc + (size_t)t * (64 * NIN * 2); LAS char* sd = lds + (t & 3) * 16384 + w * 1024;
            dma16(tb, sd); dma16(tb + 32 * NIN * 2, sd + 8192); };
        dma_tile(Tmax); dma_tile(Tmax - 1); dma_tile(Tmax - 2);
        for (int t = Tmax; t >= 0; --t) {
            if (t >= 2) ATT_WAITV(4); else if (t == 1) ATT_WAITV(2); else ATT_WAITV(0);
            ATT_BAR();
            if (t < Tmax) { bool alld = true;
#pragma unroll
                for (int k = 0; k < 8; ++k) alld = alld && (flags[(((t + 1) & 1) << 3) + k] != 0u);
                if (alld) break; }
            if (t >= 3) dma_tile(t - 3);
            unsigned done = 0u;
            if (t <= Tw) { tile_part(t, lds + (t & 3) * 16384); done = __all(R < SB_THR) ? 1u : 0u; }
            if (lane == 0) flags[((t & 1) << 3) + w] = done;
        }
        ATT_WAITV(0);
        ATT_BAR();
    }
    if (active) {
        bf16_t* orow = C.MIX + (size_t)qrow * DM + 512 + hh * 64;
#pragma unroll
        for (int dt = 0; dt < 2; ++dt)
#pragma unroll
            for (int g = 0; g < 4; ++g) { const int d = 32 * dt + 8 * g + 4 * h;
                u32x2 wv; wv.x = cvtpk(o[dt][4 * g], o[dt][4 * g + 1]); wv.y = cvtpk(o[dt][4 * g + 2], o[dt][4 * g + 3]);
                *(u32x2*)(orow + d) = wv; }
    }
    __syncthreads();
}
constexpr int N_DS = 64, N_DP = 512, N_SP = 512, N_SS = 128, N_UNITS = N_DS + N_DP + N_SP + N_SS;
}

#define XB_TMO      128
#define XB_XCNT(j)  (256  + 64 * (j))
#define XB_XSUB(j)  (1280 + 64 * (j))
#define XB_XGEN(j)  (2304 + 64 * (j))
#define XB_TOP      3328
#define XB_TOPGEN   3392
#define XCD_BAR_WORDS 3456
#define XB_SPIN_CAP (1u << 18)

__device__ __forceinline__ unsigned xb_ld(unsigned* p)              { return __hip_atomic_load(p, __ATOMIC_RELAXED, __HIP_MEMORY_SCOPE_AGENT); }
__device__ __forceinline__ unsigned xb_add(unsigned* p, unsigned v) { return __hip_atomic_fetch_add(p, v, __ATOMIC_RELAXED, __HIP_MEMORY_SCOPE_AGENT); }
__device__ __forceinline__ unsigned xb_xcc_id() { return (unsigned)__builtin_amdgcn_s_getreg((3 << 11) | 20) & 0xFu; }
#define XB_SPIN(cond, bar) do { unsigned _sp = 0; while (cond) { __builtin_amdgcn_s_sleep(1); \
    if ((++_sp & 255u) == 0u) { if (xb_ld(&(bar)[XB_TMO])) break; if (_sp > XB_SPIN_CAP) { atomicAdd(&(bar)[XB_TMO], 1u); break; } } } } while (0)

struct XcdBarrier {
    unsigned* bar; unsigned x;
    volatile LAS unsigned* st;
};

__device__ __forceinline__ XcdBarrier xcd_barrier_post(unsigned* bar, volatile LAS unsigned* st) {
    XcdBarrier b; b.bar = bar; b.x = xb_xcc_id(); b.st = st;
    if (threadIdx.x == 0) (void)xb_add(&bar[XB_XCNT(b.x)], 1u);
    return b;
}
__device__ __forceinline__ void xcd_barrier_complete(unsigned* bar, unsigned x, unsigned& nloc, unsigned& nx) {
    const unsigned G = gridDim.x * gridDim.y * gridDim.z;
    unsigned sum, cnt, mine, sp = 0u;
    for (;;) {
        sum = 0u; cnt = 0u; mine = 0u;
#pragma unroll
        for (unsigned j = 0; j < 16; ++j) { const unsigned c = xb_ld(&bar[XB_XCNT(j)]); sum += c; cnt += (c > 0u) ? 1u : 0u; mine = (j == x) ? c : mine; }
        if (sum == G) break;
        __builtin_amdgcn_s_sleep(1);
        if ((++sp & 255u) == 0u) { if (xb_ld(&bar[XB_TMO])) break; if (sp > XB_SPIN_CAP) { atomicAdd(&bar[XB_TMO], 1u); break; } }
    }
    nloc = mine > 0u ? mine : 1u; nx = cnt > 0u ? cnt : 1u;
}

__device__ __forceinline__ void xcd_barrier(const XcdBarrier& b) {
    asm volatile("s_waitcnt vmcnt(0)" ::: "memory");
    __syncthreads();
    if (threadIdx.x == 0) {
        unsigned* bar = b.bar;
        __builtin_amdgcn_s_waitcnt(0);
        unsigned nloc = b.st[0], nx = b.st[1];
        if (nloc == 0u) { xcd_barrier_complete(bar, b.x, nloc, nx); b.st[0] = nloc; b.st[1] = nx; }
        const unsigned old = xb_add(&bar[XB_XSUB(b.x)], 1u);
        const unsigned gen = old / nloc;
        if (old + 1u == (gen + 1u) * nloc) {
            __builtin_amdgcn_fence(__ATOMIC_RELEASE, "agent");
            asm volatile("s_waitcnt vmcnt(0)" ::: "memory");
            const unsigned og = xb_add(&bar[XB_TOP], 1u);
            const unsigned tg = og / nx;
            if (og + 1u == (tg + 1u) * nx) xb_add(&bar[XB_TOPGEN], 1u);
            else XB_SPIN(xb_ld(&bar[XB_TOPGEN]) == tg, bar);
            __builtin_amdgcn_fence(__ATOMIC_ACQUIRE, "agent");
            xb_add(&bar[XB_XGEN(b.x)], 1u);
            asm volatile("s_waitcnt vmcnt(0)" ::: "memory");
        } else {
            XB_SPIN(xb_ld(&bar[XB_XGEN(b.x)]) == gen, bar);
            __builtin_amdgcn_fence(__ATOMIC_ACQUIRE, "agent");
            asm volatile("s_waitcnt vmcnt(0)" ::: "memory");
        }
    }
    __syncthreads();
}

struct Params { const float* in[23]; float* out; unsigned char* ws; };

__global__ void __launch_bounds__(512, 2) fwd_megakernel(Params p_unused) {
    const __attribute__((address_space(4))) Params& p = *(const __attribute__((address_space(4))) Params*)__builtin_amdgcn_kernarg_segment_ptr();
    extern __shared__ __attribute__((aligned(16))) unsigned char lds_raw[];
    cg::grid_group grid = cg::this_grid();
    LAS unsigned char* lds = (LAS unsigned char*)lds_raw;
    const int tid = threadIdx.x, lane = tid & 63, wave = __builtin_amdgcn_readfirstlane(tid >> 6);
    const int G = gridDim.x, NGW = G * 8, gw = wave * G + (int)blockIdx.x;
    unsigned char* ws = p.ws;
    unsigned* ctl = (unsigned*)(ws + WS_CTL);
    float* mod = (float*)(ws + WS_MOD);
    bf16_t* Win_t = (bf16_t*)(ws + WS_WIN); bf16_t* Wout_t = (bf16_t*)(ws + WS_WOUT); bf16_t* Wup_t = (bf16_t*)(ws + WS_WUP); bf16_t* Wdn_t = (bf16_t*)(ws + WS_WDN);
    bf16_t* XN = (bf16_t*)(ws + WS_XN); bf16_t* U = (bf16_t*)(ws + WS_U); bf16_t* MIX = (bf16_t*)(ws + WS_MIX); bf16_t* HB = (bf16_t*)(ws + WS_HB);
    float* Y = (float*)(ws + WS_Y); float* YP = (float*)(ws + WS_YP);
    const float* xp = p.in[0]; const float* xs = p.in[1];
    volatile LAS unsigned* bst = (volatile LAS unsigned*)(lds + LDS_MISC + 32);
    if (tid < 2) bst[tid] = 0u;
    __syncthreads();
    XcdBarrier bar = xcd_barrier_post(ctl + CW_BAR, bst);

    constexpr int rall = 0;
    {
        LAS float* scr = (LAS float*)(lds + wave * 16384);
        constexpr int I_MOD = NMOD / 32, I_IN = (DM / 64) * (NIN / 32), I_OUT = (DM / 64) * (DM / 32), I_UP = (DM / 64) * (DFF / 32), I_DN = (DFF / 64) * (DM / 32);
        constexpr int NITEMS = I_IN + I_OUT + I_UP + I_DN;
        for (int rep = 0; rep < REP_P0; ++rep) {
        for (int it = (int)blockIdx.x; it < I_MOD; it += G) p0_modulate_block(p.in[2], p.in[3], p.in[8], p.in[9], mod, lds, it, tid, lane, wave);
        for (int it = gw; it < NITEMS; it += NGW) {
            int r = it;
            if (r < I_IN) { p0_transpose_item(p.in[12], DM, NIN, Win_t, scr, r, lane); continue; } r -= I_IN;
            if (r < I_OUT) { p0_transpose_item(p.in[18], DM, DM, Wout_t, scr, r, lane); continue; } r -= I_OUT;
            if (r < I_UP) { p0_transpose_item(p.in[21], DM, DFF, Wup_t, scr, r, lane); continue; } r -= I_UP;
            p0_transpose_item(p.in[22], DFF, DM, Wdn_t, scr, r, lane);
        }
        }
    }
    if (p.ws == nullptr) grid.sync();
    xcd_barrier(bar);
    for (int rep = 0; rep < REP_SYNC; ++rep) xcd_barrier(bar);
    for (int rep = 0; rep < REP_ROW; ++rep)
    for (int row = gw; row < MT; row += NGW) {
        const float* xr = row < MP ? xp + (size_t)row * DM : xs + (size_t)(row - MP) * DM;
        p1_row(xr, mod, p.in[10], XN + (size_t)row * DM, row_bi(row), lane);
    }
    xcd_barrier(bar);
    {
        pg8::Gemm g{XN, Win_t, MT, NIN, DM}; pg8::StaticOrder S; S.init(MT, NIN, G, (int)blockIdx.x, DM);
        pg8::EpiQKV E{U, p.out};
        pg8::gemm_phase<pg8::EpiQKV, pg8::StaticOrder, true, true>(lds, g, S, E);
#if REP_GEMM > 1 || defined(REP_G1)
        __syncthreads(); pg8::gemm_phase<pg8::EpiQKV, pg8::StaticOrder, true, true>(lds, g, S, E);
#endif
    }
    xcd_barrier(bar);
#ifndef NO_ATT
    {
        att::Ctx C; C.U = U; C.MIX = MIX; C.cdk = p.in[4]; C.cdv = p.in[5]; C.csk = p.in[6]; C.csv = p.in[7]; C.subg = p.in[17];
        { const float a = p.in[13][lane] * p.in[14][lane], bq = p.in[15][lane] * p.in[16][lane];
          const float lamv = __expf(wave_sum(a)) - __expf(wave_sum(bq)) + 0.2f;
          C.lam = __uint_as_float(__builtin_amdgcn_readfirstlane(__float_as_uint(lamv))); }
        LAS unsigned* qword = (LAS unsigned*)(lds + LDS_MISC);
        for (int rep = 0; rep < REP_ATT; ++rep)
        for (;;) {
            if (tid == 0) qword[0] = atomicAdd(ctl + rep + 4 * rall, 1u);
            __syncthreads();
            const int idx = (int)qword[0];
            __syncthreads();
            if (idx >= att::N_UNITS) break;
            bool is_diff, sample; int ub, uh, uu;
            if (idx < att::N_DS) { is_diff = true; sample = true; ub = idx >> 2; uh = idx & 3; uu = 0; }
            else if (idx < att::N_DS + att::N_DP) { const int j = idx - att::N_DS; is_diff = true; sample = false; ub = (j & 31) >> 2; uh = j & 3; uu = 15 - (j >> 5); }
            else if (idx < att::N_DS + att::N_DP + att::N_SP) { const int j = idx - att::N_DS - att::N_DP; is_diff = false; sample = false; ub = (j & 63) >> 3; uh = j & 7; uu = 7 - (j >> 6); }
            else { const int j = idx - att::N_DS - att::N_DP - att::N_SP; is_diff = false; sample = true; ub = j >> 3; uh = j & 7; uu = 0; }
#ifdef ATT_MASK
            if (rep > 0) { const int cls = is_diff ? (sample ? 1 : 2) : (sample ? 8 : 4); if (!(cls & ATT_MASK)) continue; }
#endif
            if (is_diff) att::diff_unit(C, (LAS char*)lds, sample, ub, uh, uu);
            else att::sb_unit(C, (LAS char*)lds, sample, ub, uh, uu);
        }
    }
#endif
    xcd_barrier(bar);
    {
        pg8::Gemm g{MIX, Wout_t, MT, DM, DM}; pg8::SplitOrder S; S.init(MP, MT, DM, G, (int)blockIdx.x, DM, NSPLIT_O);
        pg8::EpiF32 E{Y, DM, YP};
        pg8::gemm_phase<pg8::EpiF32, pg8::SplitOrder, true, true>(lds, g, S, E);
#if REP_GEMM > 1 || defined(REP_G2)
        __syncthreads(); pg8::gemm_phase<pg8::EpiF32, pg8::SplitOrder, true, true>(lds, g, S, E);
#endif
    }
    xcd_barrier(bar);
    for (int rep = 0; rep < REP_ROW; ++rep)
    for (int row = gw; row < MT; row += NGW) {
        const float* xr = row < MP ? xp + (size_t)row * DM : xs + (size_t)(row - MP) * DM;
        p5_row(xr, row < MP ? (const void*)(Y + (size_t)row * DM) : (const void*)(YP + (size_t)(row - MP) * DM), row < MP ? 1 : NSPLIT_O, mod, p.in[11], p.in[19], p.out + (size_t)row * DM, XN + (size_t)row * DM, row_bi(row), lane);
    }
    xcd_barrier(bar);
    {
        pg8::Gemm g{XN, Wup_t, MT, DFF, DM}; pg8::StaticOrder S; S.init(MT, DFF, G, (int)blockIdx.x, DM);
        pg8::EpiRelu2 E{HB, DFF};
        pg8::gemm_phase<pg8::EpiRelu2, pg8::StaticOrder, true, true>(lds, g, S, E);
#if REP_GEMM > 1 || defined(REP_G3)
        __syncthreads(); pg8::gemm_phase<pg8::EpiRelu2, pg8::StaticOrder, true, true>(lds, g, S, E);
#endif
    }
    xcd_barrier(bar);
    {
        pg8::Gemm g{HB, Wdn_t, MT, DM, DFF}; pg8::SplitOrder S; S.init(MP, MT, DM, G, (int)blockIdx.x, DFF, NSPLIT_D);
        pg8::EpiF32 E{Y, DM, YP};
        pg8::gemm_phase<pg8::EpiF32, pg8::SplitOrder, true, true>(lds, g, S, E);
#if REP_GEMM > 1 || defined(REP_G4)
        __syncthreads(); pg8::gemm_phase<pg8::EpiF32, pg8::SplitOrder, true, true>(lds, g, S, E);
#endif
    }
    xcd_barrier(bar);
    for (int row = gw; row < MT; row += NGW)
        p8_row(row < MP ? (const void*)(Y + (size_t)row * DM) : (const void*)(YP + (size_t)(row - MP) * DM), row < MP ? 1 : NSPLIT_D, mod, p.in[20], p.out + (size_t)row * DM, row_bi(row), lane);
}

extern "C" void kernel_launch(void* const* d_in, const int* in_sizes, int n_in, void* d_out, int out_size, void* d_ws, size_t ws_size, hipStream_t stream) {
    static int grid_blocks = 0;
    if (grid_blocks == 0) {
        if (n_in != 23 || ws_size < WS_END2) { fprintf(stderr, "kernel_launch: unexpected n_in %d / ws_size %zu\n", n_in, ws_size); grid_blocks = -1; return; }
        int dev = 0, cus = 0, per_cu = 0;
        hipGetDevice(&dev);
        hipDeviceGetAttribute(&cus, hipDeviceAttributeMultiprocessorCount, dev);
        hipFuncSetAttribute((const void*)fwd_megakernel, hipFuncAttributeMaxDynamicSharedMemorySize, LDS_BYTES);
        hipOccupancyMaxActiveBlocksPerMultiprocessor(&per_cu, (const void*)fwd_megakernel, 512, LDS_BYTES);
        (void)hipGetLastError();
        if (per_cu < 1) per_cu = 1;
        grid_blocks = cus * 1;
    }
    if (grid_blocks < 0) return;
    if (hipMemsetAsync((char*)d_ws + WS_CTL, 0, CTL_ZERO_BYTES, stream) != hipSuccess) { fprintf(stderr, "kernel_launch: memset failed\n"); return; }
    Params p{};
    for (int i = 0; i < 23; ++i) p.in[i] = (const float*)d_in[i];
    p.out = (float*)d_out; p.ws = (unsigned char*)d_ws;
    void* args[] = {&p};
    hipError_t e = hipLaunchCooperativeKernel((const void*)fwd_megakernel, dim3(grid_blocks), dim3(512), args, LDS_BYTES, stream);
    if (e != hipSuccess) fprintf(stderr, "cooperative launch failed: %s (grid %d)\n", hipGetErrorString(e), grid_blocks);
}
```
